# Optimizing an MI355X kernel written in HIP

```python
import math
import jax, jax.numpy as jnp
from jax import lax
import numpy as np

D_MODEL = 1024
BATCH = 8
SEQ = 4096
DEPTH = 4

GRID_W = 64
NA_HEADS = 8
NA_HEAD_DIM = 64
NA_WIN_ROWS = 8
NA_WIN_COLS = 16
MLA_HEADS = 8
MLA_Q_RANK = 256
MLA_KV_RANK = 128
MLA_NOPE_DIM = 64
MLA_ROPE_DIM = 32
MLA_V_DIM = 64
ROPE_THETA = 10000.0
D_FF = 4 * D_MODEL
Q_BLOCK = 128
NORM_EPS = 1e-6
NA_WIDTH = NA_HEADS * NA_HEAD_DIM
MLA_WIDTH = MLA_HEADS * MLA_V_DIM
IN_SIZES = (NA_WIDTH, NA_WIDTH, NA_WIDTH, MLA_Q_RANK, MLA_KV_RANK, MLA_ROPE_DIM, 2 * D_MODEL)
IN_COLS = sum(IN_SIZES)
RPB_ROWS = 2 * NA_WIN_ROWS - 1
RPB_COLS = 2 * NA_WIN_COLS - 1

kernel_name = "hybrid_natten_mla_sqrelu_adaln_encoder"


def rmsnorm(x, g):
    xf = x.astype(jnp.float32)
    y = xf * lax.rsqrt(jnp.mean(xf * xf, axis=-1, keepdims=True) + NORM_EPS)
    return (y * g.astype(jnp.float32)).astype(x.dtype)


def apply_rope(x, cos, sin):
    half = x.shape[-1] // 2
    x1, x2 = x[..., :half], x[..., half:]
    return jnp.concatenate([x1 * cos - x2 * sin, x2 * cos + x1 * sin], axis=-1)


def rope_tables(positions, dtype):
    inv_freq = 1.0 / (ROPE_THETA ** (jnp.arange(0, MLA_ROPE_DIM, 2, dtype=jnp.float32) / MLA_ROPE_DIM))
    ang = positions.astype(jnp.float32)[..., None] * inv_freq
    return jnp.cos(ang).astype(dtype), jnp.sin(ang).astype(dtype)


def split_cols(t, sizes):
    idx = []
    acc = 0
    for s in sizes[:-1]:
        acc += s
        idx.append(acc)
    return jnp.split(t, idx, axis=-1)


def neighborhood_attention(q, k, v, rpb):
    B, S, H, dh = q.shape
    rows = S // GRID_W
    kh = min(NA_WIN_ROWS, rows)
    kw = NA_WIN_COLS

    def to_grid(t):
        return t.reshape(B, rows, GRID_W, H, dh).transpose(1, 0, 3, 2, 4)

    qg, kg, vg = to_grid(q), to_grid(k), to_grid(v)
    col = jnp.arange(GRID_W)
    col_start = jnp.clip(col - kw // 2, 0, GRID_W - kw)
    col_idx = col_start[:, None] + jnp.arange(kw)
    col_off = col_idx - col[:, None] + (NA_WIN_COLS - 1)
    row = jnp.arange(rows)
    row_start = jnp.clip(row - kh // 2, 0, rows - kh)
    scale = dh ** -0.5

    def one_row(args):
        r, rs, q_r = args
        k_blk = lax.dynamic_slice_in_dim(kg, rs, kh, axis=0)
        v_blk = lax.dynamic_slice_in_dim(vg, rs, kh, axis=0)
        k_nb = k_blk[:, :, :, col_idx]
        v_nb = v_blk[:, :, :, col_idx]
        s = jnp.einsum('bhcd,ibhcjd->bhcij', q_r, k_nb).astype(jnp.float32) * scale
        row_off = rs + jnp.arange(kh) - r + (NA_WIN_ROWS - 1)
        bias = rpb[:, row_off[:, None, None], col_off[None, :, :]]
        s = s + bias.transpose(0, 2, 1, 3)[None].astype(jnp.float32)
        p = jax.nn.softmax(s.reshape(B, H, GRID_W, kh * kw), axis=-1)
        p = p.reshape(B, H, GRID_W, kh, kw).astype(v.dtype)
        return jnp.einsum('bhcij,ibhcjd->bhcd', p, v_nb)

    out = lax.map(one_row, (row, row_start, qg))
    return out.transpose(1, 0, 3, 2, 4).reshape(B, S, H * dh)


def mla_attention(c_q, c_kv, k_rope, w_uq, w_ukv, g_q, g_kv, cos, sin):
    B, S, _ = c_q.shape
    H = MLA_HEADS
    q = (rmsnorm(c_q, g_q) @ w_uq).reshape(B, S, H, MLA_NOPE_DIM + MLA_ROPE_DIM)
    q_nope, q_rope = q[..., :MLA_NOPE_DIM], q[..., MLA_NOPE_DIM:]
    q_rope = apply_rope(q_rope, cos[:, :, None], sin[:, :, None])
    kv = (rmsnorm(c_kv, g_kv) @ w_ukv).reshape(B, S, H, MLA_NOPE_DIM + MLA_V_DIM)
    k_nope, v = kv[..., :MLA_NOPE_DIM], kv[..., MLA_NOPE_DIM:]
    k_r = apply_rope(k_rope, cos, sin)
    nblk = S // Q_BLOCK
    scale = (MLA_NOPE_DIM + MLA_ROPE_DIM) ** -0.5
    qn = q_nope.reshape(B, nblk, Q_BLOCK, H, MLA_NOPE_DIM).transpose(1, 0, 3, 2, 4)
    qr = q_rope.reshape(B, nblk, Q_BLOCK, H, MLA_ROPE_DIM).transpose(1, 0, 3, 2, 4)

    def one_block(args):
        qn_b, qr_b = args
        s = (jnp.einsum('bhqd,bkhd->bhqk', qn_b, k_nope)
             + jnp.einsum('bhqr,bkr->bhqk', qr_b, k_r))
        p = jax.nn.softmax(s.astype(jnp.float32) * scale, axis=-1).astype(v.dtype)
        return jnp.einsum('bhqk,bkhd->bqhd', p, v)

    out = lax.map(one_block, (qn, qr))
    return out.transpose(1, 0, 2, 3, 4).reshape(B, S, H * MLA_V_DIM)


def setup_inputs(seed: int = 0) -> dict:
    key = jax.random.key(seed)
    ks = jax.random.split(key, 24)
    L, D = DEPTH, D_MODEL

    def w(k, shape, fan_in):
        return jax.random.normal(k, shape, jnp.float32) * (fan_in ** -0.5)

    def gain(k, shape):
        return 1.0 + 0.05 * jax.random.normal(k, shape, jnp.float32)

    x = jax.random.normal(ks[0], (BATCH, SEQ, D), jnp.float32)
    c = jax.random.normal(ks[1], (BATCH, D), jnp.float32)
    offset = jax.random.randint(ks[2], (BATCH, 1), 0, 1024, dtype=jnp.int32)
    positions = offset + jnp.arange(SEQ, dtype=jnp.int32)[None, :]
    return {
        "x": x,
        "c": c,
        "positions": positions,
        "w_ada": w(ks[3], (L, D, 6 * D), D),
        "b_ada": 0.02 * jax.random.normal(ks[4], (L, 6 * D), jnp.float32),
        "g_mix": gain(ks[5], (L, D)),
        "w_in": w(ks[6], (L, D, IN_COLS), D),
        "b_gate": 0.02 * jax.random.normal(ks[7], (L, 2 * D), jnp.float32),
        "rpb": 0.05 * jax.random.normal(ks[8], (L, NA_HEADS, RPB_ROWS, RPB_COLS), jnp.float32),
        "g_q": gain(ks[9], (L, MLA_Q_RANK)),
        "w_uq": w(ks[10], (L, MLA_Q_RANK, MLA_HEADS * (MLA_NOPE_DIM + MLA_ROPE_DIM)), MLA_Q_RANK),
        "g_kv": gain(ks[11], (L, MLA_KV_RANK)),
        "w_ukv": w(ks[12], (L, MLA_KV_RANK, MLA_HEADS * (MLA_NOPE_DIM + MLA_V_DIM)), MLA_KV_RANK),
        "w_br_na": w(ks[13], (L, NA_WIDTH, D), NA_WIDTH),
        "w_br_mla": w(ks[14], (L, MLA_WIDTH, D), MLA_WIDTH),
        "w_out": w(ks[15], (L, D, D), D),
        "g_mlp": gain(ks[16], (L, D)),
        "w_ff1": w(ks[17], (L, D, D_FF), D),
        "w_ff2": w(ks[18], (L, D_FF, D), D_FF),
        "g_final": gain(ks[19], (D,)),
    }


def reference(x, c, positions, w_ada, b_ada, g_mix, w_in, b_gate, rpb, g_q, w_uq, g_kv, w_ukv,
              w_br_na, w_br_mla, w_out, g_mlp, w_ff1, w_ff2, g_final):
    B, S, D = x.shape
    cos, sin = rope_tables(positions, x.dtype)
    c_act = jax.nn.silu(c)
    for l in range(DEPTH):
        mod = c_act @ w_ada[l] + b_ada[l]
        shift_a, scale_a, gate_a, shift_m, scale_m, gate_m = jnp.split(mod, 6, axis=-1)

        h = rmsnorm(x, g_mix[l]) * (1.0 + scale_a[:, None]) + shift_a[:, None]
        proj = h @ w_in[l]
        q_na, k_na, v_na, c_q, c_kv, k_rope, gate_logits = split_cols(proj, IN_SIZES)
        hd = (B, S, NA_HEADS, NA_HEAD_DIM)
        o_na = neighborhood_attention(q_na.reshape(hd), k_na.reshape(hd), v_na.reshape(hd), rpb[l])
        o_mla = mla_attention(c_q, c_kv, k_rope, w_uq[l], w_ukv[l], g_q[l], g_kv[l], cos, sin)
        gates = jax.nn.sigmoid((gate_logits + b_gate[l]).astype(jnp.float32)).astype(x.dtype)
        g_na, g_mla = gates[..., :D], gates[..., D:]
        merged = g_na * (o_na @ w_br_na[l]) + g_mla * (o_mla @ w_br_mla[l])
        x = x + gate_a[:, None] * (merged @ w_out[l])

        h = rmsnorm(x, g_mlp[l]) * (1.0 + scale_m[:, None]) + shift_m[:, None]
        x = x + gate_m[:, None] * (jnp.square(jax.nn.relu(h @ w_ff1[l])) @ w_ff2[l])
    return rmsnorm(x, g_final)
```

```cpp
#include <hip/hip_runtime.h>
#include <hip/hip_cooperative_groups.h>
#include <cstdio>
#include <cstdint>
namespace cg = cooperative_groups;
#ifndef MK_MULTI
#define MK_MULTI 0
#endif
namespace pg8 {
#define PG8_LAS __attribute__((address_space(3)))
typedef unsigned short bf16_t;
typedef short bf16x8 __attribute__((ext_vector_type(8)));
typedef float f32x4 __attribute__((ext_vector_type(4)));
typedef unsigned u32x4 __attribute__((ext_vector_type(4)));
constexpr int BM = 256, BK = 64, HALF = 128, HTB = HALF * BK * 2  , STAGE_BYTES = 8 * HTB, NXCD = 8, WGM = 8;

__host__ __device__ __forceinline__ int lds_byte(int r, int c) { const int st = (r >> 4) * 2 + (c >> 5), rr = r & 15, cc = c & 31, ob = rr * 64 + cc * 2; return st * 1024 + (ob ^ (((ob >> 9) & 1) << 5)); }
__host__ __device__ __forceinline__ void stage_rc(int b, int& R, int& C) { const int st = b / 1024, sb = b % 1024, swz = sb ^ (((sb >> 9) & 1) << 5); R = (st >> 1) * 16 + swz / 64; C = (st & 1) * 32 + (swz % 64) / 2; }
__host__ __device__ __forceinline__ int perm32(int rho) { const int n = rho >> 4, i = rho & 15; return 8 * (i >> 2) + 4 * n + (i & 3); }

struct Unit { int pm, pn; };
struct Gemm { const bf16_t* A; const bf16_t* Bt; int M, N, K; };

struct StaticOrder {
    int nM, nN, nwg, G, c;
    __host__ __device__ void init(int M, int N, int G_, int c_) { nM = M / BM; nN = N / BM; nwg = nM * nN; G = G_; c = c_; }
    __host__ __device__ bool next(int i, Unit& u) const {
        const long L = (long)i * G + c; if (L >= nwg) return false;
        int wgid = (int)L; { const int q = nwg / NXCD, r = nwg % NXCD, xcd = wgid % NXCD, off = wgid / NXCD; wgid = (xcd < r ? xcd * (q + 1) : r * (q + 1) + (xcd - r) * q) + off; }
        const int nig = WGM * nN, gid = wgid / nig, fm = gid * WGM, gsz = nM < WGM ? nM : WGM;
        u.pm = fm + ((wgid % nig) % gsz); u.pn = (wgid % nig) / gsz; return true;
    }
    __device__ __forceinline__ void a_ready(const Unit&) const {}
    __device__ __forceinline__ void done(const Unit&) const {}
};

__device__ __forceinline__ unsigned cvt_pk_bf16(float lo, float hi) { unsigned r; asm volatile("v_cvt_pk_bf16_f32 %0, %1, %2" : "=v"(r) : "v"(lo), "v"(hi)); return r; }
template <class E, class = void> struct MidT { static constexpr int v = 0; };
template <class E> struct MidT<E, decltype((void)E::MID_T)> { static constexpr int v = E::MID_T; };
template <class Epi, class Sched, bool ALIGN_EPI = false, bool SP2 = false>
__device__ __forceinline__ void gemm_phase(PG8_LAS unsigned char* lds, const int wave0, const Gemm g, const Sched& S, const Epi& E) {
    int lane_; asm volatile("v_mbcnt_lo_u32_b32 %0, -1, 0\n\tv_mbcnt_hi_u32_b32 %0, -1, %0" : "=v"(lane_));
    int wid_ = wave0; asm volatile("" : "+s"(wid_));
    const int wid = wid_, lane = lane_, tid = wid * 64 + lane, wr = wid >> 2, wc = wid & 3, fr = lane & 15, fq = lane >> 4;
    const int K = g.K, nt = K / BK;
    unsigned voffA, voffB;
    { int R, C; stage_rc(tid * 16, R, C); const int Rb = Epi::PERM ? ((R & ~31) + perm32(R & 31)) : R;
        voffA = (unsigned)(R * K + C) * 2u; voffB = (unsigned)(Rb * K + C) * 2u; }
    const size_t istep = (size_t)64 * K * 2;
    const size_t kstep = (size_t)(BK * 2);
    const size_t hstep = (size_t)HALF * K * 2;
    const size_t tstep = 2 * hstep;
    const unsigned ldsw = (unsigned)wid * 1024u;
    const int aoff = lds_byte(wr * 64 + fr, fq * 8), boff = lds_byte(wc * 32 + fr, fq * 8);
#define PG8_SA(b, h) (((b) * 2 + (h)) * HTB)
#define PG8_SB(b, h) ((4 + (b) * 2 + (h)) * HTB)
#define PG8_STAGE(bufoff, gbase, voff) do { const unsigned long long gb_ = (unsigned long long)(const char*)(gbase); \
        const unsigned long long ub_ = ((unsigned long long)(unsigned)__builtin_amdgcn_readfirstlane((int)(unsigned)(gb_ >> 32)) << 32) | (unsigned)__builtin_amdgcn_readfirstlane((int)(unsigned)gb_); \
        _Pragma("unroll") for (int _i = 0; _i < 2; ++_i) \
        __builtin_amdgcn_global_load_lds((const __attribute__((address_space(1))) unsigned*)(ub_ + _i * istep + (voff)), (PG8_LAS unsigned*)(lds + (bufoff) + ldsw + _i * 8192), 16, 0, 0); } while (0)
#define PG8_LDA(dst, b, h) do { _Pragma("unroll") for (int m = 0; m < 4; ++m) _Pragma("unroll") for (int k = 0; k < 2; ++k) dst[m][k] = *(const PG8_LAS bf16x8*)(lds + PG8_SA(b, h) + aoff + m * 2048 + k * 1024); } while (0)
#define PG8_LDB(dst, b, h) do { _Pragma("unroll") for (int n = 0; n < 2; ++n) _Pragma("unroll") for (int k = 0; k < 2; ++k) dst[n][k] = *(const PG8_LAS bf16x8*)(lds + PG8_SB(b, h) + boff + n * 2048 + k * 1024); } while (0)
#define PG8_MMA(ai, bj, At, Bt) do { __builtin_amdgcn_s_setprio(1); _Pragma("unroll") for (int m = 0; m < 4; ++m) _Pragma("unroll") for (int n = 0; n < 2; ++n) _Pragma("unroll") for (int k = 0; k < 2; ++k) \
        acc[ai][bj][m][n] = __builtin_amdgcn_mfma_f32_16x16x32_bf16(Bt[n][k], At[m][k], acc[ai][bj][m][n], 0, 0, 0); __builtin_amdgcn_s_setprio(0); } while (0)
#define PG8_WAIT_V(n) asm volatile("s_waitcnt vmcnt(" #n ")" ::: "memory")
#define PG8_WAIT_L(n) asm volatile("s_waitcnt lgkmcnt(" #n ")" ::: "memory")
#define PG8_BAR __builtin_amdgcn_s_barrier()
#define PG8_SCHED __builtin_amdgcn_sched_barrier(0)
    Unit cur, nxt; int ui = 0;
    if (!S.next(0, cur)) return;
    f32x4 acc[2][2][4][2];
#pragma unroll
    for (int a = 0; a < 2; ++a)
#pragma unroll
        for (int b = 0; b < 2; ++b)
#pragma unroll
            for (int m = 0; m < 4; ++m)
#pragma unroll
                for (int n = 0; n < 2; ++n) acc[a][b][m][n] = (f32x4){0.f, 0.f, 0.f, 0.f};
    bf16x8 At[4][2], B0[2][2], B1[2][2];
    const char* cA = (const char*)g.A + (size_t)cur.pm * tstep; const char* cB = (const char*)g.Bt + (size_t)cur.pn * tstep;
    S.a_ready(cur);
    if constexpr (SP2) {
        PG8_STAGE(PG8_SB(0, 0), cB, voffB); PG8_STAGE(PG8_SB(0, 1), cB + hstep, voffB); PG8_STAGE(PG8_SA(0, 0), cA, voffA); PG8_STAGE(PG8_SA(0, 1), cA + hstep, voffA);
        if (wr == 1) PG8_BAR;
        PG8_WAIT_V(2); PG8_BAR;
        PG8_STAGE(PG8_SB(1, 0), cB + kstep, voffB); PG8_STAGE(PG8_SA(1, 0), cA + kstep, voffA); PG8_STAGE(PG8_SB(1, 1), cB + hstep + kstep, voffB);
        PG8_WAIT_V(6); PG8_BAR;
    } else {
        PG8_STAGE(PG8_SB(0, 0), cB, voffB); PG8_STAGE(PG8_SA(0, 0), cA, voffA); PG8_STAGE(PG8_SB(0, 1), cB + hstep, voffB); PG8_STAGE(PG8_SA(0, 1), cA + hstep, voffA);
        if (wr == 1) PG8_BAR;
        PG8_WAIT_V(4); PG8_BAR;
        PG8_STAGE(PG8_SB(1, 0), cB + kstep, voffB); PG8_STAGE(PG8_SA(1, 0), cA + kstep, voffA); PG8_STAGE(PG8_SB(1, 1), cB + hstep + kstep, voffB);
        PG8_WAIT_V(6); PG8_BAR;
    }
    for (;;) {
        const bool has_next = S.next(ui + 1, nxt);
        const char* nA = has_next ? (const char*)g.A + (size_t)nxt.pm * tstep : cA; const char* nB = has_next ? (const char*)g.Bt + (size_t)nxt.pn * tstep : cB;
        for (int t = 0; t < nt; t += 2) {
            if constexpr (MidT<Epi>::v > 0) { if (t == MidT<Epi>::v) E.mid(acc, cur, wr, wc); }
            const bool last = (t == nt - 2);
            const char* a1 = cA + (size_t)(t + 1) * kstep;
            const char* a2 = last ? nA : cA + (size_t)(t + 2) * kstep; const char* b2 = last ? nB : cB + (size_t)(t + 2) * kstep;
            const char* a3 = a2 + kstep; const char* b3 = b2 + kstep;
            if (last && has_next) S.a_ready(nxt);
            if constexpr (SP2) {
            PG8_LDB(B0, 0, 0); PG8_LDB(B1, 0, 1); PG8_SCHED; PG8_LDA(At, 0, 0); PG8_STAGE(PG8_SA(1, 1), a1 + hstep, voffA);
            PG8_WAIT_V(8); PG8_WAIT_L(0); PG8_BAR; PG8_MMA(0, 0, At, B0); PG8_MMA(0, 1, At, B1); PG8_BAR; PG8_SCHED;
            PG8_LDA(At, 0, 1); PG8_STAGE(PG8_SB(0, 0), b2, voffB); PG8_STAGE(PG8_SB(0, 1), b2 + hstep, voffB); PG8_STAGE(PG8_SA(0, 0), a2, voffA);
            PG8_WAIT_V(8); PG8_WAIT_L(0); PG8_BAR; PG8_MMA(1, 0, At, B0); PG8_MMA(1, 1, At, B1); PG8_BAR; PG8_SCHED;
            PG8_LDB(B0, 1, 0); PG8_LDB(B1, 1, 1); PG8_SCHED; PG8_LDA(At, 1, 0); PG8_STAGE(PG8_SA(0, 1), a2 + hstep, voffA);
            PG8_WAIT_V(8); PG8_WAIT_L(0); PG8_BAR; PG8_MMA(0, 0, At, B0); PG8_MMA(0, 1, At, B1); PG8_BAR; PG8_SCHED;
            PG8_LDA(At, 1, 1); PG8_STAGE(PG8_SB(1, 0), b3, voffB); PG8_STAGE(PG8_SB(1, 1), b3 + hstep, voffB); PG8_STAGE(PG8_SA(1, 0), a3, voffA);
            PG8_WAIT_V(8); PG8_WAIT_L(0); PG8_BAR; PG8_MMA(1, 0, At, B0); PG8_MMA(1, 1, At, B1); PG8_BAR; PG8_SCHED;
            } else {
            PG8_LDB(B0, 0, 0); PG8_SCHED; PG8_LDA(At, 0, 0); PG8_STAGE(PG8_SA(1, 1), a1 + hstep, voffA);
            PG8_WAIT_L(8); PG8_BAR; PG8_WAIT_L(0); PG8_MMA(0, 0, At, B0); PG8_BAR; PG8_SCHED;
            PG8_LDB(B1, 0, 1); PG8_STAGE(PG8_SB(0, 0), b2, voffB);
            PG8_BAR; PG8_WAIT_L(0); PG8_MMA(0, 1, At, B1); PG8_BAR;
            PG8_LDA(At, 0, 1); PG8_STAGE(PG8_SA(0, 0), a2, voffA);
            PG8_BAR; PG8_WAIT_L(0); PG8_MMA(1, 0, At, B0); PG8_BAR; PG8_SCHED;
            PG8_STAGE(PG8_SB(0, 1), b2 + hstep, voffB);
            PG8_WAIT_V(6); PG8_BAR; PG8_MMA(1, 1, At, B1); PG8_BAR;
            PG8_LDB(B0, 1, 0); PG8_SCHED; PG8_LDA(At, 1, 0); PG8_STAGE(PG8_SA(0, 1), a2 + hstep, voffA);
            PG8_WAIT_L(8); PG8_BAR; PG8_WAIT_L(0); PG8_MMA(0, 0, At, B0); PG8_BAR; PG8_SCHED;
            PG8_LDB(B1, 1, 1); PG8_STAGE(PG8_SB(1, 0), b3, voffB);
            PG8_BAR; PG8_WAIT_L(0); PG8_MMA(0, 1, At, B1); PG8_BAR;
            PG8_LDA(At, 1, 1); PG8_STAGE(PG8_SA(1, 0), a3, voffA);
            PG8_BAR; PG8_WAIT_L(0); PG8_MMA(1, 0, At, B0); PG8_BAR; PG8_SCHED;
            PG8_STAGE(PG8_SB(1, 1), b3 + hstep, voffB);
            PG8_WAIT_V(6); PG8_BAR; PG8_MMA(1, 1, At, B1); PG8_BAR;
            }
        }
        if constexpr (ALIGN_EPI) { if (wr == 0) PG8_BAR; }
        if constexpr (!Epi::AFTER_DRAIN) { E(acc, cur, wr, wc, fr, fq); S.done(cur); }
        if (!has_next) break;
#pragma unroll
        for (int a = 0; a < 2; ++a)
#pragma unroll
            for (int b = 0; b < 2; ++b)
#pragma unroll
                for (int m = 0; m < 4; ++m)
#pragma unroll
                    for (int n = 0; n < 2; ++n) acc[a][b][m][n] = (f32x4){0.f, 0.f, 0.f, 0.f};
        cur = nxt; cA = nA; cB = nB; ++ui;
        if constexpr (ALIGN_EPI) { if (wr == 1) PG8_BAR; }
    }
    PG8_WAIT_V(0);
    if constexpr (!ALIGN_EPI) { if (wr == 0) PG8_BAR; }
    PG8_BAR;
    if constexpr (Epi::AFTER_DRAIN) { E.fused(acc, cur, wr, wc, fr, fq, lds, wid, lane); S.done(cur); }
#undef PG8_SA
#undef PG8_SB
#undef PG8_STAGE
#undef PG8_LDA
#undef PG8_LDB
#undef PG8_MMA
#undef PG8_WAIT_V
#undef PG8_WAIT_L
#undef PG8_BAR
#undef PG8_SCHED
}
}

constexpr int BATCH = 8, SEQ = 4096, DM = 1024, DEPTH = 4, MTOK = BATCH * SEQ, DFF = 4096;
constexpr int NIN = 3584;
constexpr float NORM_EPS = 1e-6f;
constexpr float LOG2E = 1.4426950408889634f;
constexpr int NPHASE = 2 + 14 * DEPTH;
#ifndef ONLY
#define ONLY -1
#endif
#define PH_EN(n) (ONLY < 0 || ONLY == (n))
#ifndef DBG_FINAL_SRC
#define DBG_FINAL_SRC outp
#endif

#define LAS __attribute__((address_space(3)))
#define GAS __attribute__((address_space(1)))
template <class T> __device__ __forceinline__ T* as_global(T* p) { return (T*)(GAS T*)p; }
typedef unsigned short bf16;
typedef float f32x4 __attribute__((ext_vector_type(4)));
typedef float f32x2 __attribute__((ext_vector_type(2)));
typedef float f32x16 __attribute__((ext_vector_type(16)));
typedef short bf16x8 __attribute__((ext_vector_type(8)));
typedef short s16x4 __attribute__((ext_vector_type(4)));
typedef unsigned u32x4 __attribute__((ext_vector_type(4)));
typedef unsigned u32x2 __attribute__((ext_vector_type(2)));
typedef __bf16 bf16x2_t __attribute__((ext_vector_type(2)));

constexpr size_t MiB = 1u << 20;
constexpr size_t WS_CTL = 0, WS_MOD = 1 * MiB, WS_COS = 2 * MiB, WS_SIN = 4 * MiB, WS_SSQQ = 6 * MiB, WS_SSQKV = 6 * MiB + 512 * 1024, WS_KRR = 7 * MiB;
constexpr size_t WS_WIN = 9 * MiB, WS_WVNA = 16 * MiB, WS_WUQ = 17 * MiB, WS_WUK = 17 * MiB + 512 * 1024, WS_WUV = 17 * MiB + 768 * 1024;
constexpr size_t WS_WBR = 18 * MiB,        WS_WOUT = 20 * MiB, WS_WFF1 = 22 * MiB, WS_WFF2 = 30 * MiB;
constexpr size_t WS_H = 38 * MiB;
constexpr size_t WS_GATES = 102 * MiB;
constexpr size_t WS_QKNA = 230 * MiB;
constexpr size_t WS_MERGED = 230 * MiB;
constexpr size_t WS_OCAT = 38 * MiB;
constexpr size_t WS_VTNA = 294 * MiB;
constexpr size_t WS_CQ = 326 * MiB, WS_CKV = 342 * MiB;
constexpr size_t WS_ONA = 350 * MiB;
constexpr size_t WS_QMLA = 382 * MiB;
constexpr size_t WS_TMP = 382 * MiB;
constexpr size_t WS_KNOPE = 430 * MiB;
constexpr size_t WS_VTMLA = 462 * MiB;
constexpr size_t WS_U = 102 * MiB;
constexpr size_t WS_HM = 382 * MiB;
constexpr size_t WS_SSQX = 510 * MiB;
constexpr size_t WS_SWIN = 64 * 1024, WS_SWFF = 384 * 1024;
constexpr size_t WS_RSTDA = 640 * 1024, WS_RSTDM = 768 * 1024;
constexpr size_t WS_NEED = 512 * MiB;
constexpr int LDS_BYTES = 147456;

__device__ __forceinline__ unsigned pk2(float lo, float hi) { f32x2 v = {lo, hi}; bf16x2_t b = __builtin_convertvector(v, bf16x2_t); return __builtin_bit_cast(unsigned, b); }
__device__ __forceinline__ float bflo(unsigned w) { return __builtin_bit_cast(float, w << 16); }
__device__ __forceinline__ float bfhi(unsigned w) { return __builtin_bit_cast(float, w & 0xffff0000u); }
__device__ __forceinline__ void st8bf(bf16* p, f32x4 a, f32x4 b) { u32x4 w; w.x = pk2(a.x, a.y); w.y = pk2(a.z, a.w); w.z = pk2(b.x, b.y); w.w = pk2(b.z, b.w); *(u32x4*)p = w; }
template <int X> __device__ __forceinline__ float swz_xor(float v) { return __builtin_bit_cast(float, __builtin_amdgcn_ds_swizzle(__builtin_bit_cast(int, v), 0x1f | (X << 10))); }
__device__ __forceinline__ void swap32(float v, float& lo, float& hi) { float a = v, b = v;
    asm volatile("v_nop\n\tv_nop\n\tv_permlane32_swap_b32 %0, %1" : "+v"(a), "+v"(b)); lo = a; hi = b; }
__device__ __forceinline__ float sum32(float v) { float lo, hi; swap32(v, lo, hi); return lo + hi; }
__device__ __forceinline__ float max32(float v) { float lo, hi; swap32(v, lo, hi); return fmaxf(lo, hi); }
__device__ __forceinline__ float partner32(float v, bool lower) { float lo, hi; swap32(v, lo, hi); return lower ? hi : lo; }
__device__ __forceinline__ float wave_sum(float v) {
    v += swz_xor<1>(v); v += swz_xor<2>(v); v += swz_xor<4>(v); v += swz_xor<8>(v); v += swz_xor<16>(v); return sum32(v);
}
__device__ __forceinline__ int my_lane() { int l; asm volatile("v_mbcnt_lo_u32_b32 %0, -1, 0\n\tv_mbcnt_hi_u32_b32 %0, -1, %0" : "=v"(l)); return l; }
#define LDS_WAIT() asm volatile("s_waitcnt lgkmcnt(0)" ::: "memory")

__device__ __forceinline__ void rope8(f32x4& v0, f32x4& v1, const float* cosT, const float* sinT, int row, int fq) {
    f32x4 p0, p1;
    const bool lower = fq < 2;
    p0.x = partner32(v0.x, lower); p0.y = partner32(v0.y, lower); p0.z = partner32(v0.z, lower); p0.w = partner32(v0.w, lower);
    p1.x = partner32(v1.x, lower); p1.y = partner32(v1.y, lower); p1.z = partner32(v1.z, lower); p1.w = partner32(v1.w, lower);
    const int i0 = 8 * (fq & 1);
    const f32x4 c0 = *(const f32x4*)(cosT + (size_t)row * 16 + i0), c1 = *(const f32x4*)(cosT + (size_t)row * 16 + i0 + 4);
    const f32x4 s0 = *(const f32x4*)(sinT + (size_t)row * 16 + i0), s1 = *(const f32x4*)(sinT + (size_t)row * 16 + i0 + 4);
    if (fq < 2) { v0 = v0 * c0 - p0 * s0; v1 = v1 * c1 - p1 * s1; } else { v0 = v0 * c0 + p0 * s0; v1 = v1 * c1 + p1 * s1; }
}

__device__ __forceinline__ float rstd_x(const float* ssqx, int row) {
    const f32x4 a = *(const f32x4*)(ssqx + (size_t)row * 16), b = *(const f32x4*)(ssqx + (size_t)row * 16 + 4), c = *(const f32x4*)(ssqx + (size_t)row * 16 + 8), d = *(const f32x4*)(ssqx + (size_t)row * 16 + 12);
    const f32x4 t = (a + b) + (c + d);
    return __builtin_amdgcn_rsqf(((t.x + t.y) + (t.z + t.w)) * (1.f / 1024.f) + NORM_EPS);
}
__device__ __forceinline__ int gate_src(int g) { return ((g >> 7) & 1) * 1024 + (g >> 8) * 128 + (g & 127); }
__device__ __forceinline__ int in_origcol(int n) { return n < 1024 ? n : (n < 1440 ? n + 512 : (n < 1536 ? -1 : 1952 + gate_src(n - 1536))); }

#define EPI_ARGS const f32x4 (&acc)[2][2][4][2], const pg8::Unit& u, int wr, int wc, int fr_unused, int fq_unused
#define EPI_LANE const int ln_ = my_lane(); const int fr = ln_ & 15, fq = ln_ >> 4; (void)fr_unused; (void)fq_unused;
__device__ __forceinline__ bool epi_fence() { asm volatile("" ::: "memory"); return true; }
#define FOR_AI_M _Pragma("unroll") for (int ai = 0; ai < 2; ++ai) _Pragma("unroll") for (int m = 0; m < 4; ++m) if (epi_fence())
#define FOR_AI_M_NOFENCE _Pragma("unroll") for (int ai = 0; ai < 2; ++ai) _Pragma("unroll") for (int m = 0; m < 4; ++m)
#define LOAD_ROW_SCALARS(dst, ptr) float dst[2][4]; FOR_AI_M_NOFENCE dst[ai][m] = (ptr)[rbase + ai * 128 + m * 16];

struct EpiInProj {
    static constexpr bool PERM = true, AFTER_DRAIN = false;
    unsigned char* ws; const float* bgate; float qscale;
    __device__ __forceinline__ void operator()(EPI_ARGS) const {
        EPI_LANE
        bf16* const qk = (bf16*)(ws + WS_QKNA); bf16* const cq = (bf16*)(ws + WS_CQ); bf16* const ckv = (bf16*)(ws + WS_CKV); bf16* const krr = (bf16*)(ws + WS_KRR); bf16* const gates = (bf16*)(ws + WS_GATES);
        float* const ssq_q = (float*)(ws + WS_SSQQ); float* const ssq_kv = (float*)(ws + WS_SSQKV); const float* const cosT = (const float*)(ws + WS_COS); const float* const sinT = (const float*)(ws + WS_SIN);
        const int pn = u.pn; const int rbase = u.pm * 256 + wr * 64 + fr;
        const float* const swb = (const float*)(ws + WS_SWIN) + (size_t)((u.pm * 256) >> 12) * 4000;
        LOAD_ROW_SCALARS(rsv, (const float*)(ws + WS_RSTDA))
        f32x4 sb[2][2];
#pragma unroll
        for (int bj = 0; bj < 2; ++bj) { const int ob = in_origcol(pn * 256 + bj * 128 + wc * 32), oc = ob + fq * 8;
            if (ob >= 0) { sb[bj][0] = *(const f32x4*)(swb + oc) + *(const f32x4*)(swb + 32000 + oc); sb[bj][1] = *(const f32x4*)(swb + oc + 4) + *(const f32x4*)(swb + 32000 + oc + 4); } else { sb[bj][0] = (f32x4){0.f, 0.f, 0.f, 0.f}; sb[bj][1] = sb[bj][0]; } }
#define ACCN(ai, bj, m, n) (acc[ai][bj][m][n] * rs_ + sb[bj][n])
        if (pn < 4) {
            const float sc = pn < 2 ? qscale : 1.f;
            FOR_AI_M { const int row = rbase + ai * 128 + m * 16; const float rs_ = rsv[ai][m];
#pragma unroll
                for (int bj = 0; bj < 2; ++bj) st8bf(qk + (size_t)row * 1024 + pn * 256 + bj * 128 + wc * 32 + fq * 8, ACCN(ai, bj, m, 0) * sc, ACCN(ai, bj, m, 1) * sc); }
        } else if (pn == 4) {
            FOR_AI_M { const int row = rbase + ai * 128 + m * 16; const float rs_ = rsv[ai][m]; float s = 0.f;
                f32x4 v[2][2];
#pragma unroll
                for (int bj = 0; bj < 2; ++bj)
#pragma unroll
                    for (int n = 0; n < 2; ++n) { const f32x4 x = ACCN(ai, bj, m, n); v[bj][n] = x; s += (x.x * x.x + x.y * x.y) + (x.z * x.z + x.w * x.w); }
                s += swz_xor<16>(s); s = sum32(s);
                if (fq == 0) ssq_q[(size_t)row * 4 + wc] = s;
#pragma unroll
                for (int bj = 0; bj < 2; ++bj) st8bf(cq + (size_t)row * 256 + bj * 128 + wc * 32 + fq * 8, v[bj][0], v[bj][1]); }
        } else if (pn == 5) {
            FOR_AI_M { const int row = rbase + ai * 128 + m * 16; const float rs_ = rsv[ai][m]; float s = 0.f;
                const f32x4 k0 = ACCN(ai, 0, m, 0), k1 = ACCN(ai, 0, m, 1);
                s = (k0.x * k0.x + k0.y * k0.y) + (k0.z * k0.z + k0.w * k0.w) + (k1.x * k1.x + k1.y * k1.y) + (k1.z * k1.z + k1.w * k1.w);
                s += swz_xor<16>(s); s = sum32(s);
                if (fq == 0) ssq_kv[(size_t)row * 4 + wc] = s;
                st8bf(ckv + (size_t)row * 128 + wc * 32 + fq * 8, k0, k1);
                if (wc == 0) { f32x4 v0 = ACCN(ai, 1, m, 0), v1 = ACCN(ai, 1, m, 1); rope8(v0, v1, cosT, sinT, row, fq); st8bf(krr + (size_t)row * 32 + fq * 8, v0, v1); }
            }
        } else {
            const int oc = (pn - 6) * 128 + wc * 32 + fq * 8;
            const f32x4 bn0 = *(const f32x4*)(bgate + oc), bn1 = *(const f32x4*)(bgate + oc + 4), bm0 = *(const f32x4*)(bgate + 1024 + oc), bm1 = *(const f32x4*)(bgate + 1024 + oc + 4);
            FOR_AI_M { const int row = rbase + ai * 128 + m * 16; const float rs_ = rsv[ai][m];
                f32x4 n0 = ACCN(ai, 0, m, 0) + bn0, n1 = ACCN(ai, 0, m, 1) + bn1, m0 = ACCN(ai, 1, m, 0) + bm0, m1 = ACCN(ai, 1, m, 1) + bm1;
#pragma unroll
                for (int j = 0; j < 4; ++j) {
                    const float en0 = __builtin_amdgcn_exp2f(-LOG2E * n0[j]), en1 = __builtin_amdgcn_exp2f(-LOG2E * n1[j]), em0 = __builtin_amdgcn_exp2f(-LOG2E * m0[j]), em1 = __builtin_amdgcn_exp2f(-LOG2E * m1[j]);
                    m0[j] = fmaxf(__builtin_amdgcn_rcpf(1.f + em0), 1e-18f); m1[j] = fmaxf(__builtin_amdgcn_rcpf(1.f + em1), 1e-18f);
                    n0[j] = __builtin_amdgcn_rcpf(1.f + en0) * __builtin_amdgcn_rcpf(m0[j]); n1[j] = __builtin_amdgcn_rcpf(1.f + en1) * __builtin_amdgcn_rcpf(m1[j]); }
                st8bf(gates + (size_t)row * 2048 + oc, n0, n1); st8bf(gates + (size_t)row * 2048 + 1024 + oc, m0, m1); }
        }
    }
};
#undef ACCN
struct EpiVtNa {
    static constexpr bool PERM = true, AFTER_DRAIN = false;
    unsigned char* ws;
    __device__ __forceinline__ void operator()(EPI_ARGS) const {
        EPI_LANE
        bf16* const O = (bf16*)(ws + WS_VTNA); const float* const rstd = (const float*)(ws + WS_RSTDA);
        const int rbase = u.pm * 256 + wr * 64 + fr, cbase = u.pn * 256 + wc * 32 + fq * 8;
        const float* const swb = (const float*)(ws + WS_SWIN) + (size_t)((u.pn * 256) >> 12) * 4000 + 1024;
        LOAD_ROW_SCALARS(sb0, swb) LOAD_ROW_SCALARS(sb1, swb + 32000)
        f32x4 rr[2][2];
#pragma unroll
        for (int bj = 0; bj < 2; ++bj) { rr[bj][0] = *(const f32x4*)(rstd + cbase + bj * 128); rr[bj][1] = *(const f32x4*)(rstd + cbase + bj * 128 + 4); }
        FOR_AI_M { const int row = rbase + ai * 128 + m * 16; const float sbv = sb0[ai][m] + sb1[ai][m];
#pragma unroll
            for (int bj = 0; bj < 2; ++bj) st8bf(O + (size_t)row * MTOK + cbase + bj * 128, acc[ai][bj][m][0] * rr[bj][0] + sbv, acc[ai][bj][m][1] * rr[bj][1] + sbv); }
    }
};

struct EpiQup {
    static constexpr bool PERM = true, AFTER_DRAIN = false;
    unsigned char* ws; float scale;
    __device__ __forceinline__ void operator()(EPI_ARGS) const {
        EPI_LANE
        bf16* const Q = (bf16*)(ws + WS_QMLA); const float* const ssq = (const float*)(ws + WS_SSQQ); const float* const cosT = (const float*)(ws + WS_COS); const float* const sinT = (const float*)(ws + WS_SIN);
        const int rbase = u.pm * 256 + wr * 64 + fr;
        float rsv[2][4];
#pragma unroll
        for (int ai = 0; ai < 2; ++ai) { f32x4 pp[4];
#pragma unroll
            for (int m = 0; m < 4; ++m) pp[m] = *(const f32x4*)(ssq + (size_t)(rbase + ai * 128 + m * 16) * 4);
#pragma unroll
            for (int m = 0; m < 4; ++m) rsv[ai][m] = __builtin_amdgcn_rsqf(((pp[m].x + pp[m].y) + (pp[m].z + pp[m].w)) * (1.f / 256.f) + NORM_EPS) * scale;
            epi_fence(); }
        FOR_AI_M { const int row = rbase + ai * 128 + m * 16;
            const float rs = rsv[ai][m];
#pragma unroll
            for (int bj = 0; bj < 2; ++bj) { const int g = u.pn * 8 + bj * 4 + wc; f32x4 v0 = acc[ai][bj][m][0] * rs, v1 = acc[ai][bj][m][1] * rs;
                if (g % 3 == 2) rope8(v0, v1, cosT, sinT, row, fq);
                st8bf(Q + (size_t)row * 768 + g * 32 + fq * 8, v0, v1); } }
    }
};

struct EpiKup {
    static constexpr bool PERM = true, AFTER_DRAIN = false;
    unsigned char* ws;
    __device__ __forceinline__ void operator()(EPI_ARGS) const {
        EPI_LANE
        bf16* const Kn = (bf16*)(ws + WS_KNOPE); const float* const ssq = (const float*)(ws + WS_SSQKV);
        const int rbase = u.pm * 256 + wr * 64 + fr, cbase = u.pn * 256 + wc * 32 + fq * 8;
        float rsv[2][4];
#pragma unroll
        for (int ai = 0; ai < 2; ++ai) { f32x4 pp[4];
#pragma unroll
            for (int m = 0; m < 4; ++m) pp[m] = *(const f32x4*)(ssq + (size_t)(rbase + ai * 128 + m * 16) * 4);
#pragma unroll
            for (int m = 0; m < 4; ++m) rsv[ai][m] = __builtin_amdgcn_rsqf(((pp[m].x + pp[m].y) + (pp[m].z + pp[m].w)) * (1.f / 128.f) + NORM_EPS);
            epi_fence(); }
        FOR_AI_M { const int row = rbase + ai * 128 + m * 16;
            const float rs = rsv[ai][m];
#pragma unroll
            for (int bj = 0; bj < 2; ++bj) st8bf(Kn + (size_t)row * 512 + cbase + bj * 128, acc[ai][bj][m][0] * rs, acc[ai][bj][m][1] * rs); }
    }
};

struct EpiVtUp {
    static constexpr bool PERM = true, AFTER_DRAIN = false;
    unsigned char* ws;
    __device__ __forceinline__ void operator()(EPI_ARGS) const {
        EPI_LANE
        bf16* const Vt = (bf16*)(ws + WS_VTMLA); const float* const ssq = (const float*)(ws + WS_SSQKV);
        const int rbase = u.pm * 256 + wr * 64 + fr, cbase = u.pn * 256 + wc * 32 + fq * 8;
#pragma unroll
        for (int bj = 0; bj < 2; ++bj) {
            f32x4 r0, r1;
#pragma unroll
            for (int j = 0; j < 4; ++j) { const f32x4 p = *(const f32x4*)(ssq + (size_t)(cbase + bj * 128 + j) * 4), q = *(const f32x4*)(ssq + (size_t)(cbase + bj * 128 + 4 + j) * 4);
                r0[j] = __builtin_amdgcn_rsqf(((p.x + p.y) + (p.z + p.w)) * (1.f / 128.f) + NORM_EPS); r1[j] = __builtin_amdgcn_rsqf(((q.x + q.y) + (q.z + q.w)) * (1.f / 128.f) + NORM_EPS); }
            FOR_AI_M { const int row = rbase + ai * 128 + m * 16; st8bf(Vt + (size_t)row * MTOK + cbase + bj * 128, acc[ai][bj][m][0] * r0, acc[ai][bj][m][1] * r1); }
        }
    }
};

struct EpiBr {
    static constexpr bool PERM = true, AFTER_DRAIN = false; static constexpr int MID_T = 8;
    unsigned char* ws;
    __device__ __forceinline__ void mid(f32x4 (&acc)[2][2][4][2], const pg8::Unit& u, int wr, int wc) const {
        const int ln_ = my_lane(); const int fr = ln_ & 15, fq = ln_ >> 4;
        const bf16* const gates = (const bf16*)(ws + WS_GATES);
        const int rbase = u.pm * 256 + wr * 64 + fr, cbase = u.pn * 256 + wc * 32 + fq * 8;
#pragma unroll
        for (int ai = 0; ai < 2; ++ai) {
            u32x4 ga[4][2];
#pragma unroll
            for (int m = 0; m < 4; ++m)
#pragma unroll
                for (int bj = 0; bj < 2; ++bj) ga[m][bj] = *(const u32x4*)(gates + (size_t)(rbase + ai * 128 + m * 16) * 2048 + cbase + bj * 128);
            epi_fence();
#pragma unroll
            for (int m = 0; m < 4; ++m)
#pragma unroll
                for (int bj = 0; bj < 2; ++bj) { const u32x4 a = ga[m][bj];
                    const f32x4 n0 = {bflo(a.x), bfhi(a.x), bflo(a.y), bfhi(a.y)}, n1 = {bflo(a.z), bfhi(a.z), bflo(a.w), bfhi(a.w)};
                    acc[ai][bj][m][0] = acc[ai][bj][m][0] * n0; acc[ai][bj][m][1] = acc[ai][bj][m][1] * n1; }
        }
    }
    __device__ __forceinline__ void operator()(EPI_ARGS) const {
        EPI_LANE
        const bf16* const gates = (const bf16*)(ws + WS_GATES); bf16* const merged = (bf16*)(ws + WS_MERGED);
        const int rbase = u.pm * 256 + wr * 64 + fr, cbase = u.pn * 256 + wc * 32 + fq * 8;
#pragma unroll
        for (int ai = 0; ai < 2; ++ai) {
            u32x4 gb[4][2];
#pragma unroll
            for (int m = 0; m < 4; ++m)
#pragma unroll
                for (int bj = 0; bj < 2; ++bj) gb[m][bj] = *(const u32x4*)(gates + (size_t)(rbase + ai * 128 + m * 16) * 2048 + 1024 + cbase + bj * 128);
            epi_fence();
#pragma unroll
            for (int m = 0; m < 4; ++m)
#pragma unroll
                for (int bj = 0; bj < 2; ++bj) { const u32x4 b = gb[m][bj];
                    f32x4 m0 = {bflo(b.x), bfhi(b.x), bflo(b.y), bfhi(b.y)}, m1 = {bflo(b.z), bfhi(b.z), bflo(b.w), bfhi(b.w)};
#pragma unroll
                    for (int j = 0; j < 4; ++j) { m0[j] = fmaxf(m0[j], 1e-18f); m1[j] = fmaxf(m1[j], 1e-18f); }
                    st8bf(merged + (size_t)(rbase + ai * 128 + m * 16) * 1024 + cbase + bj * 128, acc[ai][bj][m][0] * m0, acc[ai][bj][m][1] * m1); }
        }
    }
};
constexpr int RES_ROWS = 2;
struct EpiResid {
    static constexpr bool PERM = true, AFTER_DRAIN = false;
    const float* xres; float* out; const float* gate;
    bf16* Hn; const float* gn; const float* scn; float* ssqx;
    __device__ __forceinline__ void operator()(EPI_ARGS) const {
        EPI_LANE
        const int rbase = u.pm * 256 + wr * 64 + fr, cbase = u.pn * 256 + wc * 32 + fq * 8;
        const int bb = (u.pm * 256) >> 12;
        const float* gb = gate + (size_t)bb * 6144;
        f32x4 g[2][2], Gm[2][2];
#pragma unroll
        for (int bj = 0; bj < 2; ++bj) { const int col = cbase + bj * 128; g[bj][0] = *(const f32x4*)(gb + col); g[bj][1] = *(const f32x4*)(gb + col + 4);
            Gm[bj][0] = (f32x4){0.f, 0.f, 0.f, 0.f}; Gm[bj][1] = Gm[bj][0];
            if (Hn) { const float* sp = scn + (size_t)bb * 6144 + col; Gm[bj][0] = *(const f32x4*)(gn + col) * (*(const f32x4*)sp + 1.f); Gm[bj][1] = *(const f32x4*)(gn + col + 4) * (*(const f32x4*)(sp + 4) + 1.f); } }
#pragma unroll
        for (int ai = 0; ai < 2; ++ai)
#pragma unroll
        for (int mh = 0; mh < 4; mh += RES_ROWS) {
            f32x4 xr[4][2][2];
#pragma unroll
            for (int m = mh; m < mh + RES_ROWS; ++m)
#pragma unroll
                for (int bj = 0; bj < 2; ++bj) { const float* xp = xres + (size_t)(rbase + ai * 128 + m * 16) * 1024 + cbase + bj * 128; xr[m][bj][0] = *(const f32x4*)xp; xr[m][bj][1] = *(const f32x4*)(xp + 4); }
            epi_fence();
#pragma unroll
            for (int m = mh; m < mh + RES_ROWS; ++m) { const int row = rbase + ai * 128 + m * 16; float sv = 0.f;
#pragma unroll
                for (int bj = 0; bj < 2; ++bj) { const size_t o = (size_t)row * 1024 + cbase + bj * 128;
                    const f32x4 x0 = xr[m][bj][0] + g[bj][0] * acc[ai][bj][m][0], x1 = xr[m][bj][1] + g[bj][1] * acc[ai][bj][m][1];
                    *(f32x4*)(out + o) = x0; *(f32x4*)(out + o + 4) = x1;
                    if (Hn) { st8bf(Hn + o, x0 * Gm[bj][0], x1 * Gm[bj][1]);
                        sv += (x0.x * x0.x + x0.y * x0.y) + (x0.z * x0.z + x0.w * x0.w) + (x1.x * x1.x + x1.y * x1.y) + (x1.z * x1.z + x1.w * x1.w); } }
                if (Hn) { sv += swz_xor<16>(sv); sv = sum32(sv); if (fq == 0) ssqx[(size_t)row * 16 + u.pn * 4 + wc] = sv; } }
        }
    }
};
struct EpiFF1 {
    static constexpr bool PERM = true, AFTER_DRAIN = false;
    unsigned char* ws;
    __device__ __forceinline__ void operator()(EPI_ARGS) const {
        EPI_LANE
        bf16* const U = (bf16*)(ws + WS_U);
        const int rbase = u.pm * 256 + wr * 64 + fr, cbase = u.pn * 256 + wc * 32 + fq * 8;
        LOAD_ROW_SCALARS(rsv, (const float*)(ws + WS_RSTDM))
        const float* const swb = (const float*)(ws + WS_SWFF) + (size_t)((u.pm * 256) >> 12) * 4096 + cbase;
        f32x4 sb[2][2];
#pragma unroll
        for (int bj = 0; bj < 2; ++bj) { sb[bj][0] = *(const f32x4*)(swb + bj * 128) + *(const f32x4*)(swb + 32768 + bj * 128); sb[bj][1] = *(const f32x4*)(swb + bj * 128 + 4) + *(const f32x4*)(swb + 32768 + bj * 128 + 4); }
        FOR_AI_M { const int row = rbase + ai * 128 + m * 16; const float rs_ = rsv[ai][m];
#pragma unroll
            for (int bj = 0; bj < 2; ++bj) { f32x4 v0 = acc[ai][bj][m][0] * rs_ + sb[bj][0], v1 = acc[ai][bj][m][1] * rs_ + sb[bj][1];
#pragma unroll
                for (int j = 0; j < 4; ++j) { const float a = fmaxf(v0[j], 0.f), b = fmaxf(v1[j], 0.f); v0[j] = a * a; v1[j] = b * b; }
                st8bf(U + (size_t)row * DFF + cbase + bj * 128, v0, v1); } }
    }
};

template <class Epi>
__device__ __forceinline__ void run_gemm(LAS unsigned char* lds, int wave0, int bid, int G, const bf16* A, const bf16* Bt, int Mr, int Nc, int K, const Epi& E) {
    { GAS const bf16* Ag = (GAS const bf16*)A; GAS const bf16* Bg = (GAS const bf16*)Bt; asm volatile("" : "+s"(Ag), "+s"(Bg)); A = (const bf16*)Ag; Bt = (const bf16*)Bg; }
    pg8::Gemm g{A, Bt, Mr, Nc, K}; pg8::StaticOrder S; S.init(Mr, Nc, G, bid);
    pg8::gemm_phase<Epi, pg8::StaticOrder, true, true>((PG8_LAS unsigned char*)lds, wave0, g, S, E);
}

__device__ __forceinline__ void conv_item(const float* W, int K, int N, int col0, const float* g, bf16* WT, int row0, int k0, LAS float* scr, int lane, int pitch, int kd) {
    f32x4 v[8];
    const int kr = lane >> 3, n4 = (lane & 7) * 4;
#pragma unroll
    for (int i = 0; i < 8; ++i) v[i] = (col0 >= 0) ? *(const f32x4*)(W + (size_t)(k0 + 8 * i + kr) * N + col0 + n4) : (f32x4){0.f, 0.f, 0.f, 0.f};
    if (g) {
#pragma unroll
        for (int i = 0; i < 8; ++i) v[i] = v[i] * g[k0 + 8 * i + kr];
    }
#pragma unroll
    for (int i = 0; i < 8; ++i) { LAS float* d = scr + (8 * i + kr) * 33 + n4; d[0] = v[i].x; d[1] = v[i].y; d[2] = v[i].z; d[3] = v[i].w; }
    LDS_WAIT();
    const int c = lane & 7;
#pragma unroll
    for (int j = 0; j < 4; ++j) { const int n = (lane >> 3) + 8 * j; const LAS float* s = scr + (8 * c) * 33 + n;
        u32x4 o; o.x = pk2(s[0 * 33], s[1 * 33]); o.y = pk2(s[2 * 33], s[3 * 33]); o.z = pk2(s[4 * 33], s[5 * 33]); o.w = pk2(s[6 * 33], s[7 * 33]);
        *(u32x4*)(WT + (size_t)(row0 + n) * pitch + kd + k0 + 8 * c) = o; }
    LDS_WAIT();
}
__device__ __forceinline__ int conv_map(int kind, int n0, int off) {
    if (kind == 0) return n0 + off;
    if (kind == 1) return n0 < 1024 ? n0 : (n0 < 1440 ? n0 + 512 : (n0 < 1536 ? -1 : 1952 + ((((n0 - 1536) >> 7) & 1) * 1024 + ((n0 - 1536) >> 8) * 128 + ((n0 - 1536) & 127))));
    if (kind == 2) return (n0 >> 6) * 128 + (n0 & 63);
    return (n0 >> 6) * 128 + 64 + (n0 & 63);
}

struct Args { const void* in[20]; float* out; unsigned char* ws; int ph_lo, ph_hi; };
typedef const __attribute__((address_space(4))) Args* ArgsP;

__device__ __forceinline__ void phase_convert(ArgsP ap, int l, LAS unsigned char* lds, int gw, int NGW, int wave, int lane) {
    LAS float* scr = (LAS float*)(lds + wave * 8704);
    unsigned char* ws = as_global(ap->ws);
    const float* w_in = as_global((const float*)ap->in[6]) + (size_t)l * 1024 * 4000;
    const float* g_q = as_global((const float*)ap->in[9]) + l * 256;   const float* w_uq = as_global((const float*)ap->in[10]) + (size_t)l * 256 * 768;
    const float* g_kv = as_global((const float*)ap->in[11]) + l * 128; const float* w_ukv = as_global((const float*)ap->in[12]) + (size_t)l * 128 * 1024;
    const float* w_bn = as_global((const float*)ap->in[13]) + (size_t)l * 512 * 1024; const float* w_bm = as_global((const float*)ap->in[14]) + (size_t)l * 512 * 1024;
    const float* w_o = as_global((const float*)ap->in[15]) + (size_t)l * 1024 * 1024;
    const float* w_1 = as_global((const float*)ap->in[17]) + (size_t)l * 1024 * 4096; const float* w_2 = as_global((const float*)ap->in[18]) + (size_t)l * 4096 * 1024;
    constexpr int NITEMS = 16 * 112 + 16 * 16 + 4 * 24 + 2 * 16 + 2 * 16 + 8 * 32 + 8 * 32 + 16 * 32 + 16 * 128 + 64 * 32;
    for (int it = gw; it < NITEMS; it += NGW) {
        int r = it;
#define CONV_JOB(Wp, Kk, Nn, ndst, kind, off, gp, WTp) CONV_JOB2(Wp, Kk, Nn, ndst, kind, off, gp, WTp, Kk, 0)
#define CONV_JOB2(Wp, Kk, Nn, ndst, kind, off, gp, WTp, pitch_, kd_) { constexpr int nb_ = (ndst) / 32, cnt_ = ((Kk) / 64) * nb_; \
            if (r < cnt_) { const int kb_ = r / nb_, n0_ = (r % nb_) * 32; conv_item(Wp, Kk, Nn, conv_map(kind, n0_, off), gp, (bf16*)(ws + WTp), n0_, kb_ * 64, scr, lane, pitch_, kd_); continue; } r -= cnt_; }
        CONV_JOB(w_in, 1024, 4000, NIN, 1, 0, (const float*)nullptr, WS_WIN)
        CONV_JOB(w_in, 1024, 4000, 512, 0, 1024, (const float*)nullptr, WS_WVNA)
        CONV_JOB(w_uq, 256, 768, 768, 0, 0, g_q, WS_WUQ)
        CONV_JOB(w_ukv, 128, 1024, 512, 2, 0, g_kv, WS_WUK)
        CONV_JOB(w_ukv, 128, 1024, 512, 3, 0, g_kv, WS_WUV)
        CONV_JOB2(w_bn, 512, 1024, 1024, 0, 0, (const float*)nullptr, WS_WBR, 1024, 0)
        CONV_JOB2(w_bm, 512, 1024, 1024, 0, 0, (const float*)nullptr, WS_WBR, 1024, 512)
        CONV_JOB(w_o, 1024, 1024, 1024, 0, 0, (const float*)nullptr, WS_WOUT)
        CONV_JOB(w_1, 1024, 4096, 4096, 0, 0, (const float*)nullptr, WS_WFF1)
        CONV_JOB(w_2, 4096, 1024, 1024, 0, 0, (const float*)nullptr, WS_WFF2)
#undef CONV_JOB
#undef CONV_JOB2
    }
}

__device__ __forceinline__ void phase_rstd(const float* ssqx, float* rstd, int tid, int bid, int G) {
    for (int row = bid * 512 + tid; row < MTOK; row += G * 512) rstd[row] = rstd_x(ssqx, row);
}
__device__ __forceinline__ void phase_xg(const float* x, const float* g, const float* modl, int scale_off, bf16* h, float* rstd, int gw, int NGW, int lane) {
    for (int row = gw; row < MTOK; row += NGW) {
        const f32x4* xr = (const f32x4*)(x + (size_t)row * DM) + lane;
        f32x4 v[4]; float s = 0.f;
#pragma unroll
        for (int j = 0; j < 4; ++j) { v[j] = xr[64 * j]; s += (v[j].x * v[j].x + v[j].y * v[j].y) + (v[j].z * v[j].z + v[j].w * v[j].w); }
        s = wave_sum(s);
        if (lane == 0) rstd[row] = __builtin_amdgcn_rsqf(s * (1.f / 1024.f) + NORM_EPS);
        const float* mb = modl + (size_t)(row >> 12) * 6144;
#pragma unroll
        for (int j = 0; j < 4; ++j) { const int col = 256 * j + 4 * lane;
            const f32x4 gg = *(const f32x4*)(g + col), sc = *(const f32x4*)(mb + scale_off + col);
            const f32x4 y = v[j] * gg * (sc + 1.f);
            u32x2 o; o.x = pk2(y.x, y.y); o.y = pk2(y.z, y.w); *(u32x2*)(h + (size_t)row * DM + col) = o; }
    }
}
__device__ __forceinline__ void phase_sw(const float* w_in, const float* w_ff1, const float* modl, float* swin, float* swff, LAS unsigned char* lds, int tid, int bid, int G) {
    LAS float* sh = (LAS float*)lds;
    LAS float* red = (LAS float*)(lds + 65536);
    for (int i = tid; i < 16384; i += 512) { const int w = i >> 13, b = (i >> 10) & 7, k = i & 1023; sh[i] = modl[(size_t)b * 6144 + (w ? 3072 : 0) + k]; }
    __syncthreads();
    const int kg = tid >> 6, jl = tid & 63;
    for (int it2 = bid; it2 < 2 * (63 + 64); it2 += G) {
        const int item = it2 >> 1, kh = it2 & 1;
        const bool ff = item >= 63; const int j0 = (ff ? item - 63 : item) * 64, N = ff ? 4096 : 4000;
        const float* W = ff ? w_ff1 : w_in; const LAS float* shp = sh + (ff ? 8192 : 0) + kh * 512 + kg * 64;
        const bool colok = j0 + jl < N;
        float acc[8];
#pragma unroll
        for (int b = 0; b < 8; ++b) acc[b] = 0.f;
        const float* wp = W + (size_t)(kh * 512 + kg * 64) * N + j0 + (colok ? jl : 0);
#pragma unroll
        for (int k0 = 0; k0 < 64; k0 += 16) {
            float w[16];
#pragma unroll
            for (int q = 0; q < 16; ++q) w[q] = wp[(size_t)(k0 + q) * N];
#pragma unroll
            for (int q = 0; q < 16; ++q)
#pragma unroll
                for (int b = 0; b < 8; ++b) acc[b] += shp[b * 1024 + k0 + q] * w[q];
        }
#pragma unroll
        for (int b = 0; b < 8; ++b) red[(kg * 64 + jl) * 8 + b] = acc[b];
        __syncthreads();
        { const int b = tid >> 6; float sv = 0.f;
#pragma unroll
          for (int k2 = 0; k2 < 8; ++k2) sv += red[(k2 * 64 + jl) * 8 + b];
          if (colok) (ff ? swff : swin)[(size_t)(kh * 8 + b) * N + j0 + jl] = sv; }
        __syncthreads();
    }
}
__device__ __forceinline__ void phase_final_norm(float* x, const float* g, int gw, int NGW, int lane, const float* xsrc, const float* xalt) {
    constexpr int RB = 4;
    for (int row0 = gw; row0 < MTOK; row0 += RB * NGW) {
        f32x4 v[RB][4]; float rs[RB];
#pragma unroll
        for (int q = 0; q < RB; ++q) { const int row = row0 + q * NGW;
            const f32x4* xs = (const f32x4*)(xsrc + (size_t)(row < MTOK ? row : row0) * DM) + lane;
#pragma unroll
            for (int j = 0; j < 4; ++j) v[q][j] = xs[64 * j]; }
#pragma unroll
        for (int q = 0; q < RB; ++q) { float s = 0.f;
#pragma unroll
            for (int j = 0; j < 4; ++j) s += (v[q][j].x * v[q][j].x + v[q][j].y * v[q][j].y) + (v[q][j].z * v[q][j].z + v[q][j].w * v[q][j].w);
            rs[q] = 1.f / sqrtf(wave_sum(s) * (1.f / DM) + NORM_EPS); }
#pragma unroll
        for (int q = 0; q < RB; ++q) { const int row = row0 + q * NGW;
            if (row < MTOK) { f32x4* xr = (f32x4*)(x + (size_t)row * DM) + lane;
#pragma unroll
                for (int j = 0; j < 4; ++j) { const f32x4 gg = *(const f32x4*)(g + 256 * j + 4 * lane); xr[64 * j] = v[q][j] * rs[q] * gg; } } }
    }
    (void)xalt;
}

__device__ __forceinline__ void phase_p0(ArgsP ap, LAS unsigned char* lds, int tid, int bid, int G) {
    const float* c = as_global((const float*)ap->in[1]); const int* pos = as_global((const int*)ap->in[2]);
    const float* w_ada = as_global((const float*)ap->in[3]); const float* b_ada = as_global((const float*)ap->in[4]);
    unsigned char* wsb = as_global(ap->ws); float* mod = (float*)(wsb + WS_MOD); float* cosT = (float*)(wsb + WS_COS); float* sinT = (float*)(wsb + WS_SIN);
    for (int idx = bid * 512 + tid; idx < MTOK * 16; idx += G * 512) {
        const int row = idx >> 4, i = idx & 15;
        const float inv = __builtin_amdgcn_exp2f(-(float)i * 0.830482023721841f);
        const float ang = (float)pos[row] * inv;
        double t = (double)ang * 0.15915494309189533577; t -= rint(t);
        const float tf = (float)t;
        cosT[idx] = __builtin_amdgcn_cosf(tf); sinT[idx] = __builtin_amdgcn_sinf(tf);
    }
    LAS float* sc = (LAS float*)lds;
    LAS float* red = (LAS float*)(lds + 32768);
    for (int i = tid; i < 8192; i += 512) { const float v = c[i]; sc[i] = v / (1.f + __expf(-v)); }
    __syncthreads();
    const int kg = tid >> 6, jl = tid & 63;
    for (int item = bid; item < DEPTH * 96; item += G) {
        const int l = item / 96, j0 = (item % 96) * 64;
        float acc[8];
#pragma unroll
        for (int b = 0; b < 8; ++b) acc[b] = 0.f;
        const float* wp = w_ada + ((size_t)l * 1024 + kg * 128) * 6144 + j0 + jl;
#pragma unroll 1
        for (int k0 = 0; k0 < 128; k0 += 16) {
            float w[16];
#pragma unroll
            for (int q = 0; q < 16; ++q) w[q] = wp[(size_t)(k0 + q) * 6144];
#pragma unroll
            for (int q = 0; q < 16; ++q)
#pragma unroll
                for (int b = 0; b < 8; ++b) acc[b] += sc[b * 1024 + kg * 128 + k0 + q] * w[q];
        }
#pragma unroll
        for (int b = 0; b < 8; ++b) red[(kg * 64 + jl) * 8 + b] = acc[b];
        __syncthreads();
        { const int b = tid >> 6; float s = b_ada[l * 6144 + j0 + jl];
#pragma unroll
          for (int k2 = 0; k2 < 8; ++k2) s += red[(k2 * 64 + jl) * 8 + b];
          mod[((size_t)l * 8 + b) * 6144 + j0 + jl] = s; }
        __syncthreads();
    }
}

#define MFMA32(a, b, c) __builtin_amdgcn_mfma_f32_32x32x16_bf16((a), (b), (c), 0, 0, 0)
__device__ __forceinline__ bf16x8 pack8(const f32x16& x, int s) {
    u32x4 p; p.x = pk2(x[8 * s], x[8 * s + 1]); p.y = pk2(x[8 * s + 2], x[8 * s + 3]); p.z = pk2(x[8 * s + 4], x[8 * s + 5]); p.w = pk2(x[8 * s + 6], x[8 * s + 7]);
    return __builtin_bit_cast(bf16x8, p);
}
__device__ __forceinline__ f32x16 zero16() { f32x16 z;
#pragma unroll
    for (int i = 0; i < 16; ++i) z[i] = 0.f;
    return z; }

constexpr int MLA_KP = 208, MLA_VP = 144, MLA_VOFF = 64 * MLA_KP, MLA_BUF = MLA_VOFF + 64 * MLA_VP;
__device__ __forceinline__ void phase_mla(const bf16* Q, const bf16* Kn, const bf16* krr, const bf16* Vt, bf16* O, LAS unsigned char* lds, int tid, int wave, int lane, int bid, int G) {
    const int r = lane & 31, hh = lane >> 5;
    for (int unit = bid; unit < BATCH * 8 * 16; unit += G) {
        int qb = unit & 15, bh = unit >> 4;
        if (G == 256) { const int w = unit & 255, xcd = w & 7, slot = w >> 3; bh = (unit >> 8) * 16 + xcd * 2 + (slot >> 4); qb = slot & 15; }
        const int b = bh >> 3, h = bh & 7;
        const int tok0 = b * SEQ, q0 = tok0 + qb * 256 + wave * 32;
        bf16x8 qf[6];
#pragma unroll
        for (int s = 0; s < 6; ++s) qf[s] = *(const bf16x8*)(Q + (size_t)(q0 + r) * 768 + h * 96 + 16 * s + 8 * hh);
        f32x16 o0 = zero16(), o1 = zero16(); float mrun = 0.f, lrun = 0.f;
        f32x16 negm = zero16();
        const bf16* gA = Kn + (size_t)(tok0 + (tid >> 3)) * 512 + h * 64 + (tid & 7) * 8;   const int dA = (tid >> 3) * MLA_KP + (tid & 7) * 16;
        const bf16* gB = krr + (size_t)(tok0 + (tid >> 3)) * 32 + (tid & 7) * 4;               const int dB = (tid >> 3) * MLA_KP + 128 + (tid & 7) * 8;
        const bf16* gV = Vt + (size_t)(h * 64 + (tid >> 3)) * MTOK + tok0 + (tid & 7) * 8;    const int dV = MLA_VOFF + (tid >> 3) * MLA_VP + (16 * ((tid & 7) >> 1) + 4 * (tid & 1)) * 2;
        u32x4 ra, rv; u32x2 rb;
        ra = *(const u32x4*)gA; rv = *(const u32x4*)gV; rb = *(const u32x2*)gB;
        *(LAS u32x4*)(lds + dA) = ra; *(LAS u32x2*)(lds + dB) = rb;
        *(LAS u32x2*)(lds + dV) = (u32x2){rv.x, rv.y}; *(LAS u32x2*)(lds + dV + 16) = (u32x2){rv.z, rv.w};
        ra = *(const u32x4*)(gA + (size_t)64 * 512); rv = *(const u32x4*)(gV + 64); rb = *(const u32x2*)(gB + (size_t)64 * 32);
        __syncthreads();
        for (int kt = 0; kt < SEQ / 64; ++kt) {
            const int cur = kt & 1; LAS unsigned char* Kb = lds + cur * MLA_BUF; LAS unsigned char* Vb = Kb + MLA_VOFF;
            const bool more = kt + 1 < SEQ / 64;
            if (more) { LAS unsigned char* nb = lds + (cur ^ 1) * MLA_BUF;
                *(LAS u32x4*)(nb + dA) = ra; *(LAS u32x2*)(nb + dB) = rb;
                *(LAS u32x2*)(nb + dV) = (u32x2){rv.x, rv.y}; *(LAS u32x2*)(nb + dV + 16) = (u32x2){rv.z, rv.w}; }
            { const int t2 = kt + 2 < SEQ / 64 ? kt + 2 : SEQ / 64 - 1;
              ra = *(const u32x4*)(gA + (size_t)t2 * 64 * 512); rv = *(const u32x4*)(gV + t2 * 64); rb = *(const u32x2*)(gB + (size_t)t2 * 64 * 32); }
            f32x16 s0, s1;
#pragma unroll
            for (int s = 0; s < 6; ++s) {
                const bf16x8 k0 = *(const LAS bf16x8*)(Kb + r * MLA_KP + (16 * s + 8 * hh) * 2);
                const bf16x8 k1 = *(const LAS bf16x8*)(Kb + (32 + r) * MLA_KP + (16 * s + 8 * hh) * 2);
                if (s == 0) { s0 = MFMA32(k0, qf[0], negm); s1 = MFMA32(k1, qf[0], negm); } else { s0 = MFMA32(k0, qf[s], s0); s1 = MFMA32(k1, qf[s], s1); }
            }
            float mxa = fmaxf(s0[0], s0[1]), mxb = fmaxf(s0[8], s0[9]), mxc = fmaxf(s1[0], s1[1]), mxd = fmaxf(s1[8], s1[9]);
#pragma unroll
            for (int i = 2; i < 8; ++i) { mxa = fmaxf(mxa, s0[i]); mxb = fmaxf(mxb, s0[8 + i]); mxc = fmaxf(mxc, s1[i]); mxd = fmaxf(mxd, s1[8 + i]); }
            float mx = max32(fmaxf(fmaxf(mxa, mxb), fmaxf(mxc, mxd)));
            if (kt == 0 || __builtin_amdgcn_ballot_w64(mx > 8.f) != 0) {
                const float d = kt == 0 ? mx : fmaxf(mx, 0.f), alpha = kt == 0 ? 1.f : __builtin_amdgcn_exp2f(-d); mrun += d; lrun *= alpha;
#pragma unroll
                for (int i = 0; i < 16; ++i) { s0[i] -= d; s1[i] -= d; negm[i] -= d; o0[i] *= alpha; o1[i] *= alpha; }
            }
            float lsa = 0.f, lsb = 0.f, lsc = 0.f, lsd = 0.f;
#pragma unroll
            for (int i = 0; i < 8; ++i) { s0[i] = __builtin_amdgcn_exp2f(s0[i]); s0[8 + i] = __builtin_amdgcn_exp2f(s0[8 + i]); s1[i] = __builtin_amdgcn_exp2f(s1[i]); s1[8 + i] = __builtin_amdgcn_exp2f(s1[8 + i]);
                lsa += s0[i]; lsb += s0[8 + i]; lsc += s1[i]; lsd += s1[8 + i]; }
            lrun += (lsa + lsb) + (lsc + lsd);
#pragma unroll
            for (int kb = 0; kb < 2; ++kb)
#pragma unroll
                for (int s = 0; s < 2; ++s) {
                    const bf16x8 pf = pack8(kb ? s1 : s0, s);
                    const int ko = (32 * kb + 16 * s + 8 * hh) * 2;
                    const bf16x8 va = *(const LAS bf16x8*)(Vb + r * MLA_VP + ko), vc = *(const LAS bf16x8*)(Vb + (32 + r) * MLA_VP + ko);
                    o0 = MFMA32(va, pf, o0);
                    o1 = MFMA32(vc, pf, o1);
                }
            __syncthreads();
        }
        const float inv = 1.f / sum32(lrun);
        bf16* op = O + (size_t)(q0 + r) * 1024 + 512 + h * 64 + 4 * hh;
#pragma unroll
        for (int g = 0; g < 4; ++g) {
            u32x2 w0, w1; w0.x = pk2(o0[4 * g] * inv, o0[4 * g + 1] * inv); w0.y = pk2(o0[4 * g + 2] * inv, o0[4 * g + 3] * inv);
            w1.x = pk2(o1[4 * g] * inv, o1[4 * g + 1] * inv); w1.y = pk2(o1[4 * g + 2] * inv, o1[4 * g + 3] * inv);
            *(u32x2*)(op + 8 * g) = w0; *(u32x2*)(op + 32 + 8 * g) = w1;
        }
    }
}

constexpr int NA_KP = 144, NA_VP = 144, NA_VOFF = 64 * NA_KP, NA_BUF = NA_VOFF + 64 * NA_VP, NA_BIAS = 2 * NA_BUF;
__device__ __forceinline__ void phase_na(const bf16* qk, const bf16* vt, const float* rpbl, bf16* O, LAS unsigned char* lds, int tid, int wave, int lane, int bid, int G) {
    LAS float* bias = (LAS float*)(lds + NA_BIAS);
    const int r32 = lane & 31, hh = lane >> 5;
    for (int ub = bid; ub < BATCH * 8 * 16; ub += G) {
        int bh = ub >> 4, rg = ub & 15;
        if (G == 256) { const int w = ub & 255, xcd = w & 7, slot = w >> 3; bh = (ub >> 8) * 16 + xcd * 2 + (slot >> 4); rg = slot & 15; }
        const int b = bh >> 3, h = bh & 7;
        for (int i = tid; i < 15 * 128; i += 512) { const int dcv = (i & 127) - 48; bias[i] = (dcv >= 0 && dcv <= 30) ? rpbl[h * 465 + (i >> 7) * 31 + dcv] * LOG2E : 0.f; }
        const int gr0 = rg * 4, gr = gr0 + (wave >> 1), half = wave & 1;
        const int rs = min(max(gr - 4, 0), 56);
        const int krlo = min(max(gr0 - 4, 0), 56), nrows = min(max(gr0 - 1, 0), 56) + 8 - krlo;
        const int c = half * 32 + r32, cs = min(max(c - 8, 0), 48);
        const size_t qtok = (size_t)b * SEQ + gr * 64 + c;
        bf16x8 qf[4];
#pragma unroll
        for (int s = 0; s < 4; ++s) qf[s] = *(const bf16x8*)(qk + qtok * 1024 + h * 64 + 16 * s + 8 * hh);
        f32x16 o0 = zero16(), o1 = zero16(); float mrun = -1e30f, lrun = 0.f;
        float mk[2][16];
#pragma unroll
        for (int t = 0; t < 2; ++t)
#pragma unroll
            for (int e = 0; e < 16; ++e) { const int kc = 32 * t + (e & 3) + 8 * (e >> 2) + 4 * hh; mk[t][e] = ((kc >= cs) && (kc < cs + 16)) ? 0.f : -INFINITY; }
        const int lanebase = 4 * hh - c + 15 + 48;
        const bf16* gK = qk + ((size_t)b * SEQ + krlo * 64 + (tid >> 3)) * 1024 + 512 + h * 64 + (tid & 7) * 8;  const int dK = (tid >> 3) * NA_KP + (tid & 7) * 16;
        const bf16* gV = vt + (size_t)(h * 64 + (tid >> 3)) * MTOK + (size_t)b * SEQ + krlo * 64 + (tid & 7) * 8; const int dV = NA_VOFF + (tid >> 3) * NA_VP + (16 * ((tid & 7) >> 1) + 4 * (tid & 1)) * 2;
        u32x4 rk = *(const u32x4*)gK, rv = *(const u32x4*)gV;
        *(LAS u32x4*)(lds + dK) = rk; *(LAS u32x2*)(lds + dV) = (u32x2){rv.x, rv.y}; *(LAS u32x2*)(lds + dV + 16) = (u32x2){rv.z, rv.w};
        __syncthreads();
        for (int j = 0; j < nrows; ++j) {
            const int kr = krlo + j, cur = j & 1; const bool more = j + 1 < nrows;
            LAS unsigned char* Kb = lds + cur * NA_BUF; LAS unsigned char* Vb = Kb + NA_VOFF;
            if (more) { rk = *(const u32x4*)(gK + (size_t)(j + 1) * 64 * 1024); rv = *(const u32x4*)(gV + (j + 1) * 64); }
            if (kr >= rs && kr < rs + 8) {
                const LAS float* brow = bias + (kr - gr + 7) * 128 + lanebase;
#pragma unroll
                for (int t = 0; t < 2; ++t) {
                    f32x16 sc = zero16();
#pragma unroll
                    for (int s = 0; s < 4; ++s) { const bf16x8 kf = *(const LAS bf16x8*)(Kb + (32 * t + r32) * NA_KP + (16 * s + 8 * hh) * 2); sc = MFMA32(kf, qf[s], sc); }
                    float mx = -INFINITY;
#pragma unroll
                    for (int e = 0; e < 16; ++e) { sc[e] = (sc[e] + brow[32 * t + (e & 3) + 8 * (e >> 2)]) + mk[t][e]; mx = fmaxf(mx, sc[e]); }
                    mx = max32(mx);
                    if (__builtin_amdgcn_ballot_w64(mx > mrun + 8.f) != 0) {
                        const float mnew = fmaxf(mrun, mx), alpha = __builtin_amdgcn_exp2f(mrun - mnew); mrun = mnew; lrun *= alpha;
#pragma unroll
                        for (int e = 0; e < 16; ++e) { o0[e] *= alpha; o1[e] *= alpha; }
                    }
                    float ls = 0.f;
#pragma unroll
                    for (int e = 0; e < 16; ++e) { sc[e] = __builtin_amdgcn_exp2f(sc[e] - mrun); ls += sc[e]; }
                    lrun += ls;
#pragma unroll
                    for (int s = 0; s < 2; ++s) {
                        const bf16x8 pf = pack8(sc, s);
                        const int ko = (32 * t + 16 * s + 8 * hh) * 2;
                        const bf16x8 va = *(const LAS bf16x8*)(Vb + r32 * NA_VP + ko), vc = *(const LAS bf16x8*)(Vb + (32 + r32) * NA_VP + ko);
                        o0 = MFMA32(va, pf, o0);
                        o1 = MFMA32(vc, pf, o1);
                    }
                }
            }
            if (more) { LAS unsigned char* nb = lds + (cur ^ 1) * NA_BUF;
                *(LAS u32x4*)(nb + dK) = rk; *(LAS u32x2*)(nb + dV) = (u32x2){rv.x, rv.y}; *(LAS u32x2*)(nb + dV + 16) = (u32x2){rv.z, rv.w}; }
            __syncthreads();
        }
        const float inv = 1.f / sum32(lrun);
        bf16* op = O + qtok * 1024 + h * 64 + 4 * hh;
#pragma unroll
        for (int g = 0; g < 4; ++g) {
            u32x2 w0, w1; w0.x = pk2(o0[4 * g] * inv, o0[4 * g + 1] * inv); w0.y = pk2(o0[4 * g + 2] * inv, o0[4 * g + 3] * inv);
            w1.x = pk2(o1[4 * g] * inv, o1[4 * g + 1] * inv); w1.y = pk2(o1[4 * g + 2] * inv, o1[4 * g + 3] * inv);
            *(u32x2*)(op + 8 * g) = w0; *(u32x2*)(op + 32 + 8 * g) = w1;
        }
    }
}

#define XB_TMO      128
#define XB_XCNT(j)  (256  + 64 * (j))
#define XB_XSUB(j)  (1280 + 64 * (j))
#define XB_XGEN(j)  (2304 + 64 * (j))
#define XB_TOP      3328
#define XB_TOPGEN   3392
#define XCD_BAR_WORDS 3456
#define XB_SPIN_CAP (1u << 18)

__device__ __forceinline__ unsigned xb_ld(unsigned* p)              { return __hip_atomic_load(p, __ATOMIC_RELAXED, __HIP_MEMORY_SCOPE_AGENT); }
__device__ __forceinline__ unsigned xb_add(unsigned* p, unsigned v) { return __hip_atomic_fetch_add(p, v, __ATOMIC_RELAXED, __HIP_MEMORY_SCOPE_AGENT); }
__device__ __forceinline__ unsigned xb_xcc_id() { return (unsigned)__builtin_amdgcn_s_getreg((3 << 11) | 20) & 0xFu; }
#define XB_SPIN(cond, bar) do { unsigned _sp = 0; while (cond) { __builtin_amdgcn_s_sleep(1); \
    if ((++_sp & 255u) == 0u) { if (xb_ld(&(bar)[XB_TMO])) break; if (_sp > XB_SPIN_CAP) { atomicAdd(&(bar)[XB_TMO], 1u); break; } } } } while (0)

struct XcdBarrier {
    unsigned* bar; unsigned x;
    volatile LAS unsigned* st;
};

__device__ __forceinline__ XcdBarrier xcd_barrier_post(unsigned* bar, volatile LAS unsigned* st, bool leader) {
    XcdBarrier b; b.bar = bar; b.x = xb_xcc_id(); b.st = st;
    if (leader) (void)xb_add(&bar[XB_XCNT(b.x)], 1u);
    return b;
}
__device__ __forceinline__ void xcd_barrier_complete(unsigned* bar, unsigned x, unsigned& nloc, unsigned& nx) {
    const unsigned G = gridDim.x * gridDim.y * gridDim.z;
    unsigned sum, cnt, mine, sp = 0u;
    for (;;) {
        sum = 0u; cnt = 0u; mine = 0u;
#pragma unroll
        for (unsigned j = 0; j < 16; ++j) { const unsigned c = xb_ld(&bar[XB_XCNT(j)]); sum += c; cnt += (c > 0u) ? 1u : 0u; mine = (j == x) ? c : mine; }
        if (sum == G) break;
        __builtin_amdgcn_s_sleep(1);
        if ((++sp & 255u) == 0u) { if (xb_ld(&bar[XB_TMO])) break; if (sp > XB_SPIN_CAP) { atomicAdd(&bar[XB_TMO], 1u); break; } }
    }
    nloc = mine > 0u ? mine : 1u; nx = cnt > 0u ? cnt : 1u;
}

__device__ __forceinline__ void xcd_barrier(const XcdBarrier& b, bool leader) {
    asm volatile("s_waitcnt vmcnt(0)" ::: "memory");
    __syncthreads();
    if (leader) {
        unsigned* bar = b.bar;
        __builtin_amdgcn_s_waitcnt(0);
        unsigned nloc = b.st[0], nx = b.st[1];
        if (nloc == 0u) { xcd_barrier_complete(bar, b.x, nloc, nx); b.st[0] = nloc; b.st[1] = nx; }
        const unsigned old = xb_add(&bar[XB_XSUB(b.x)], 1u);
        const unsigned gen = old / nloc;
        if (old + 1u == (gen + 1u) * nloc) {
            __builtin_amdgcn_fence(__ATOMIC_RELEASE, "agent");
            asm volatile("s_waitcnt vmcnt(0)" ::: "memory");
            const unsigned og = xb_add(&bar[XB_TOP], 1u);
            const unsigned tg = og / nx;
            if (og + 1u == (tg + 1u) * nx) xb_add(&bar[XB_TOPGEN], 1u);
            else XB_SPIN(xb_ld(&bar[XB_TOPGEN]) == tg, bar);
            __builtin_amdgcn_fence(__ATOMIC_ACQUIRE, "agent");
            xb_add(&bar[XB_XGEN(b.x)], 1u);
            asm volatile("s_waitcnt vmcnt(0)" ::: "memory");
        } else {
            XB_SPIN(xb_ld(&bar[XB_XGEN(b.x)]) == gen, bar);
            __builtin_amdgcn_fence(__ATOMIC_ACQUIRE, "agent");
            asm volatile("s_waitcnt vmcnt(0)" ::: "memory");
        }
    }
    __syncthreads();
}

constexpr int NSTEP_L = 14;
__global__ void __launch_bounds__(512, 2) mega(Args a) {
    extern __shared__ __attribute__((aligned(16))) unsigned char lds_raw[];
    LAS unsigned char* lds = (LAS unsigned char*)lds_raw;
    const int wave0 = __builtin_amdgcn_readfirstlane((int)threadIdx.x >> 6);
    const int ph_lo = a.ph_lo, ph_hi = a.ph_hi;
    { volatile LAS unsigned* bst0 = (volatile LAS unsigned*)(lds + 131072 + 512);
      if (threadIdx.x < 4) bst0[threadIdx.x] = 0u; }
    volatile LAS unsigned* bst = (volatile LAS unsigned*)(lds + 131072 + 512);
    __syncthreads();
    (void)xcd_barrier_post((unsigned*)as_global(a.ws + WS_CTL), bst, threadIdx.x == 0);
    for (int ph = ph_lo; ph < ph_hi; ++ph) {
        ArgsP ap = (ArgsP)__builtin_amdgcn_kernarg_segment_ptr(); asm volatile("" : "+s"(ap));
        float* const outp = as_global(ap->out);
        GAS unsigned char* wsg = (GAS unsigned char*)ap->ws; asm volatile("" : "+s"(wsg)); unsigned char* const ws = (unsigned char*)wsg;
        float* mod = (float*)(ws + WS_MOD);
        int bid = (int)blockIdx.x, G = (int)gridDim.x; asm volatile("" : "+s"(bid), "+s"(G));
#define TIDS() const int wave = wave0, lane = my_lane(), tid = wave * 64 + lane; \
        const int gw = bid * 8 + wave, NGW = G * 8; (void)gw; (void)NGW; (void)lane; (void)tid
        bool sync_after = true;
#ifdef DBG_STOP
        if (ph > DBG_STOP && ph < NPHASE - 1) continue;
#endif
        if (ph == 0) { if (PH_EN(10)) { TIDS(); phase_p0(ap, lds, tid, bid, G); __syncthreads(); phase_convert(ap, 0, lds, gw, NGW, wave, lane); } }
        else if (ph == NPHASE - 1) { if (PH_EN(11)) { TIDS(); phase_final_norm(outp, as_global((const float*)ap->in[19]), gw, NGW, lane, DBG_FINAL_SRC, as_global((const float*)ap->in[0])); } }
        else {
            const int l = (ph - 1) / NSTEP_L, st = (ph - 1) % NSTEP_L;
            const float* modl = mod + (size_t)l * 8 * 6144;
            const float* xin = (l == 0) ? as_global((const float*)ap->in[0]) : outp;
            sync_after = !(st == 1 || st == 3 || st == 4 || st == 5 || st == 8);
#ifdef PROBE_MASK
            for (int rep_ = 0; rep_ < (((PROBE_MASK >> st) & 1) ? 2 : 1); ++rep_)
#endif
            switch (st) {
            case 0: if (PH_EN(0)) {
                TIDS();
                if (l > 0) phase_convert(ap, l, lds, gw, NGW, wave, lane);
                __syncthreads();
                phase_sw(as_global((const float*)ap->in[6]) + (size_t)l * 1024 * 4000, as_global((const float*)ap->in[17]) + (size_t)l * 1024 * 4096, modl, (float*)(ws + WS_SWIN), (float*)(ws + WS_SWFF), lds, tid, bid, G);
                if (l == 0) phase_xg(xin, as_global((const float*)ap->in[5]), modl, 1024, (bf16*)(ws + WS_H), (float*)(ws + WS_RSTDA), gw, NGW, lane);
                else phase_rstd((const float*)(ws + WS_SSQX), (float*)(ws + WS_RSTDA), tid, bid, G);
            } break;
            case 1: if (PH_EN(1)) {
                EpiInProj E{ws, as_global((const float*)ap->in[7]) + l * 2048, 0.125f * LOG2E};
                run_gemm(lds, wave0, bid, G, (const bf16*)(ws + WS_H), (const bf16*)(ws + WS_WIN), MTOK, NIN, 1024, E);
            } break;
            case 2: if (PH_EN(2)) {
                EpiVtNa E2{ws};
                run_gemm(lds, wave0, bid, G, (const bf16*)(ws + WS_WVNA), (const bf16*)(ws + WS_H), 512, MTOK, 1024, E2);
            } break;
            case 3: if (PH_EN(3)) {
                TIDS();
                phase_na((const bf16*)(ws + WS_QKNA), (const bf16*)(ws + WS_VTNA), as_global((const float*)ap->in[8]) + (size_t)l * 8 * 465, (bf16*)(ws + WS_OCAT), lds, tid, wave, lane, bid, G);
#ifdef PROBE_NA2
                phase_na((const bf16*)(ws + WS_QKNA), (const bf16*)(ws + WS_VTNA), as_global((const float*)ap->in[8]) + (size_t)l * 8 * 465, (bf16*)(ws + WS_OCAT), lds, tid, wave, lane, bid, G);
#endif
            } break;
            case 4: if (PH_EN(4)) {
                EpiQup Eq{ws, 0.10206207261596577f * LOG2E};
                run_gemm(lds, wave0, bid, G, (const bf16*)(ws + WS_CQ), (const bf16*)(ws + WS_WUQ), MTOK, 768, 256, Eq);
            } break;
            case 5: if (PH_EN(5)) {
                EpiKup Ek{ws};
                run_gemm(lds, wave0, bid, G, (const bf16*)(ws + WS_CKV), (const bf16*)(ws + WS_WUK), MTOK, 512, 128, Ek);
            } break;
            case 6: if (PH_EN(6)) {
                EpiVtUp Ev{ws};
                run_gemm(lds, wave0, bid, G, (const bf16*)(ws + WS_WUV), (const bf16*)(ws + WS_CKV), 512, MTOK, 128, Ev);
            } break;
            case 7: if (PH_EN(7)) {
                TIDS();
                phase_mla((const bf16*)(ws + WS_QMLA), (const bf16*)(ws + WS_KNOPE), (const bf16*)(ws + WS_KRR), (const bf16*)(ws + WS_VTMLA), (bf16*)(ws + WS_OCAT), lds, tid, wave, lane, bid, G);
#ifdef PROBE_MLA2
                __syncthreads(); phase_mla((const bf16*)(ws + WS_QMLA), (const bf16*)(ws + WS_KNOPE), (const bf16*)(ws + WS_KRR), (const bf16*)(ws + WS_VTMLA), (bf16*)(ws + WS_OCAT), lds, tid, wave, lane, bid, G);
#endif
            } break;
            case 8: break;
            case 9: if (PH_EN(9)) {
                EpiBr E2{ws};
                run_gemm(lds, wave0, bid, G, (const bf16*)(ws + WS_OCAT), (const bf16*)(ws + WS_WBR), MTOK, 1024, 1024, E2);
            } break;
            case 10: if (PH_EN(12)) {
                EpiResid E{xin, outp, modl + 2048, (bf16*)(ws + WS_HM), as_global((const float*)ap->in[16]) + l * DM, modl + 4096, (float*)(ws + WS_SSQX)};
                run_gemm(lds, wave0, bid, G, (const bf16*)(ws + WS_MERGED), (const bf16*)(ws + WS_WOUT), MTOK, 1024, 1024, E);
            } break;
            case 11: if (PH_EN(13)) {
                TIDS();
                phase_rstd((const float*)(ws + WS_SSQX), (float*)(ws + WS_RSTDM), tid, bid, G);
            } break;
            case 12: if (PH_EN(14)) {
                EpiFF1 E{ws};
                run_gemm(lds, wave0, bid, G, (const bf16*)(ws + WS_HM), (const bf16*)(ws + WS_WFF1), MTOK, DFF, 1024, E);
            } break;
            default: if (PH_EN(15)) {
                const bool nxt = l + 1 < DEPTH; const float* modn = modl + (size_t)8 * 6144;
                EpiResid E{outp, outp, modl + 5120, nxt ? (bf16*)(ws + WS_H) : (bf16*)nullptr, as_global((const float*)ap->in[5]) + (l + 1) * DM, modn + 1024, (float*)(ws + WS_SSQX)};
                run_gemm(lds, wave0, bid, G, (const bf16*)(ws + WS_U), (const bf16*)(ws + WS_WFF2), MTOK, 1024, DFF, E);
            } break;
            }
        }
#ifdef DBG_STOP
        sync_after = true;
#endif
        if (sync_after && ph + 1 < ph_hi) { if (ph_hi > (1 << 20)) cg::this_grid().sync();
            { XcdBarrier xb; xb.bar = (unsigned*)(ws + WS_CTL); xb.x = xb_xcc_id(); xb.st = (volatile LAS unsigned*)(lds + 131072 + 512); xcd_barrier(xb, wave0 == 0 && my_lane() == 0); } }
    }
}

extern "C" void kernel_launch(void* const* d_in, const int* in_sizes, int n_in, void* d_out, int out_size, void* d_ws, size_t ws_size, hipStream_t stream) {
    static int grid = 0;
    if (grid == 0) {
        if (n_in != 20 || in_sizes[0] != MTOK * DM || out_size != MTOK * DM || ws_size < WS_NEED) {
            fprintf(stderr, "kernel_launch: unexpected shapes (n_in %d, in0 %d, out %d, ws %zu); nothing launched\n", n_in, n_in > 0 ? in_sizes[0] : -1, out_size, ws_size); grid = -1; return; }
        int dev = 0, cus = 0, per_cu = 0;
        hipGetDevice(&dev); hipDeviceGetAttribute(&cus, hipDeviceAttributeMultiprocessorCount, dev);
        hipFuncSetAttribute((const void*)mega, hipFuncAttributeMaxDynamicSharedMemorySize, LDS_BYTES);
        hipOccupancyMaxActiveBlocksPerMultiprocessor(&per_cu, (const void*)mega, 512, LDS_BYTES);
        if (per_cu < 1) per_cu = 1;
        grid = cus * per_cu;
        (void)hipGetLastError();
    }
    if (grid < 0) return;
    (void)hipMemsetAsync((char*)d_ws + WS_CTL, 0, 65536, stream);
    Args a{};
    for (int i = 0; i < 20; ++i) a.in[i] = d_in[i];
    a.out = (float*)d_out; a.ws = (unsigned char*)d_ws;
#if MK_MULTI
    for (int ph = 0; ph < NPHASE; ++ph) { a.ph_lo = ph; a.ph_hi = ph + 1; hipLaunchKernelGGL(mega, dim3(grid), dim3(512), LDS_BYTES, stream, a); }
#else
    a.ph_lo = 0; a.ph_hi = NPHASE;
    void* args[] = {&a};
    hipError_t e = hipLaunchCooperativeKernel((const void*)mega, dim3(grid), dim3(512), args, LDS_BYTES, stream);
    if (e != hipSuccess) fprintf(stderr, "cooperative launch failed: %s (grid %d)\n", hipGetErrorString(e), grid);
#endif
}
```

```cpp
#include <hip/hip_runtime.h>
#include <hip/hip_cooperative_groups.h>
#include <cstdio>
#include <cstdint>
namespace cg = cooperative_groups;
#ifndef MK_MULTI
#define MK_MULTI 0
#endif
namespace pg8 {
#define PG8_LAS __attribute__((address_space(3)))
typedef unsigned short bf16_t;
typedef short bf16x8 __attribute__((ext_vector_type(8)));
typedef float f32x4 __attribute__((ext_vector_type(4)));
typedef unsigned u32x4 __attribute__((ext_vector_type(4)));
constexpr int BM = 256, BK = 64, HALF = 128, HTB = HALF * BK * 2  , STAGE_BYTES = 8 * HTB, NXCD = 8, WGM = 8;

__host__ __device__ __forceinline__ int lds_byte(int r, int c) { const int st = (r >> 4) * 2 + (c >> 5), rr = r & 15, cc = c & 31, ob = rr * 64 + cc * 2; return st * 1024 + (ob ^ (((ob >> 9) & 1) << 5)); }
__host__ __device__ __forceinline__ void stage_rc(int b, int& R, int& C) { const int st = b / 1024, sb = b % 1024, swz = sb ^ (((sb >> 9) & 1) << 5); R = (st >> 1) * 16 + swz / 64; C = (st & 1) * 32 + (swz % 64) / 2; }
__host__ __device__ __forceinline__ int perm32(int rho) { const int n = rho >> 4, i = rho & 15; return 8 * (i >> 2) + 4 * n + (i & 3); }

struct Unit { int pm, pn; };
struct Gemm { const bf16_t* A; const bf16_t* Bt; int M, N, K; };

struct StaticOrder {
    int nM, nN, nwg, G, c;
    __host__ __device__ void init(int M, int N, int G_, int c_) { nM = M / BM; nN = N / BM; nwg = nM * nN; G = G_; c = c_; }
    __host__ __device__ bool next(int i, Unit& u) const {
        const long L = (long)i * G + c; if (L >= nwg) return false;
        int wgid = (int)L; { const int q = nwg / NXCD, r = nwg % NXCD, xcd = wgid % NXCD, off = wgid / NXCD; wgid = (xcd < r ? xcd * (q + 1) : r * (q + 1) + (xcd - r) * q) + off; }
        const int nig = WGM * nN, gid = wgid / nig, fm = gid * WGM, gsz = nM < WGM ? nM : WGM;
        u.pm = fm + ((wgid % nig) % gsz); u.pn = (wgid % nig) / gsz; return true;
    }
    __device__ __forceinline__ void a_ready(const Unit&) const {}
    __device__ __forceinline__ void done(const Unit&) const {}
};

__device__ __forceinline__ unsigned cvt_pk_bf16(float lo, float hi) { unsigned r; asm volatile("v_cvt_pk_bf16_f32 %0, %1, %2" : "=v"(r) : "v"(lo), "v"(hi)); return r; }
template <class E, class = void> struct MidT { static constexpr int v = 0; };
template <class E> struct MidT<E, decltype((void)E::MID_T)> { static constexpr int v = E::MID_T; };
template <class Epi, class Sched, bool ALIGN_EPI = false, bool SP2 = false>
__device__ __forceinline__ void gemm_phase(PG8_LAS unsigned char* lds, const int wave0, const Gemm g, const Sched& S, const Epi& E) {
    int lane_; asm volatile("v_mbcnt_lo_u32_b32 %0, -1, 0\n\tv_mbcnt_hi_u32_b32 %0, -1, %0" : "=v"(lane_));
    int wid_ = wave0; asm volatile("" : "+s"(wid_));
    const int wid = wid_, lane = lane_, tid = wid * 64 + lane, wr = wid >> 2, wc = wid & 3, fr = lane & 15, fq = lane >> 4;
    const int K = g.K, nt = K / BK;
    unsigned voffA, voffB;
    { int R, C; stage_rc(tid * 16, R, C); const int Rb = Epi::PERM ? ((R & ~31) + perm32(R & 31)) : R;
        voffA = (unsigned)(R * K + C) * 2u; voffB = (unsigned)(Rb * K + C) * 2u; }
    const size_t istep = (size_t)64 * K * 2;
    const size_t kstep = (size_t)(BK * 2);
    const size_t hstep = (size_t)HALF * K * 2;
    const size_t tstep = 2 * hstep;
    const unsigned ldsw = (unsigned)wid * 1024u;
    const int aoff = lds_byte(wr * 64 + fr, fq * 8), boff = lds_byte(wc * 32 + fr, fq * 8);
#define PG8_SA(b, h) (((b) * 2 + (h)) * HTB)
#define PG8_SB(b, h) ((4 + (b) * 2 + (h)) * HTB)
#define PG8_STAGE(bufoff, gbase, voff) do { const unsigned long long gb_ = (unsigned long long)(const char*)(gbase); \
        const unsigned long long ub_ = ((unsigned long long)(unsigned)__builtin_amdgcn_readfirstlane((int)(unsigned)(gb_ >> 32)) << 32) | (unsigned)__builtin_amdgcn_readfirstlane((int)(unsigned)gb_); \
        _Pragma("unroll") for (int _i = 0; _i < 2; ++_i) \
        __builtin_amdgcn_global_load_lds((const __attribute__((address_space(1))) unsigned*)(ub_ + _i * istep + (voff)), (PG8_LAS unsigned*)(lds + (bufoff) + ldsw + _i * 8192), 16, 0, 0); } while (0)
#define PG8_LDA(dst, b, h) do { _Pragma("unroll") for (int m = 0; m < 4; ++m) _Pragma("unroll") for (int k = 0; k < 2; ++k) dst[m][k] = *(const PG8_LAS bf16x8*)(lds + PG8_SA(b, h) + aoff + m * 2048 + k * 1024); } while (0)
#define PG8_LDB(dst, b, h) do { _Pragma("unroll") for (int n = 0; n < 2; ++n) _Pragma("unroll") for (int k = 0; k < 2; ++k) dst[n][k] = *(const PG8_LAS bf16x8*)(lds + PG8_SB(b, h) + boff + n * 2048 + k * 1024); } while (0)
#define PG8_MMA(ai, bj, At, Bt) do { __builtin_amdgcn_s_setprio(1); _Pragma("unroll") for (int m = 0; m < 4; ++m) _Pragma("unroll") for (int n = 0; n < 2; ++n) _Pragma("unroll") for (int k = 0; k < 2; ++k) \
        acc[ai][bj][m][n] = __builtin_amdgcn_mfma_f32_16x16x32_bf16(Bt[n][k], At[m][k], acc[ai][bj][m][n], 0, 0, 0); __builtin_amdgcn_s_setprio(0); } while (0)
#define PG8_WAIT_V(n) asm volatile("s_waitcnt vmcnt(" #n ")" ::: "memory")
#define PG8_WAIT_L(n) asm volatile("s_waitcnt lgkmcnt(" #n ")" ::: "memory")
#define PG8_BAR __builtin_amdgcn_s_barrier()
#define PG8_SCHED __builtin_amdgcn_sched_barrier(0)
    Unit cur, nxt; int ui = 0;
    if (!S.next(0, cur)) return;
    f32x4 acc[2][2][4][2];
#pragma unroll
    for (int a = 0; a < 2; ++a)
#pragma unroll
        for (int b = 0; b < 2; ++b)
#pragma unroll
            for (int m = 0; m < 4; ++m)
#pragma unroll
                for (int n = 0; n < 2; ++n) acc[a][b][m][n] = (f32x4){0.f, 0.f, 0.f, 0.f};
    bf16x8 At[4][2], B0[2][2], B1[2][2];
    const char* cA = (const char*)g.A + (size_t)cur.pm * tstep; const char* cB = (const char*)g.Bt + (size_t)cur.pn * tstep;
    S.a_ready(cur);
    if constexpr (SP2) {
        PG8_STAGE(PG8_SB(0, 0), cB, voffB); PG8_STAGE(PG8_SB(0, 1), cB + hstep, voffB); PG8_STAGE(PG8_SA(0, 0), cA, voffA); PG8_STAGE(PG8_SA(0, 1), cA + hstep, voffA);
        if (wr == 1) PG8_BAR;
        PG8_WAIT_V(2); PG8_BAR;
        PG8_STAGE(PG8_SB(1, 0), cB + kstep, voffB); PG8_STAGE(PG8_SA(1, 0), cA + kstep, voffA); PG8_STAGE(PG8_SB(1, 1), cB + hstep + kstep, voffB);
        PG8_WAIT_V(6); PG8_BAR;
    } else {
        PG8_STAGE(PG8_SB(0, 0), cB, voffB); PG8_STAGE(PG8_SA(0, 0), cA, voffA); PG8_STAGE(PG8_SB(0, 1), cB + hstep, voffB); PG8_STAGE(PG8_SA(0, 1), cA + hstep, voffA);
        if (wr == 1) PG8_BAR;
        PG8_WAIT_V(4); PG8_BAR;
        PG8_STAGE(PG8_SB(1, 0), cB + kstep, voffB); PG8_STAGE(PG8_SA(1, 0), cA + kstep, voffA); PG8_STAGE(PG8_SB(1, 1), cB + hstep + kstep, voffB);
        PG8_WAIT_V(6); PG8_BAR;
    }
    for (;;) {
        const bool has_next = S.next(ui + 1, nxt);
        const char* nA = has_next ? (const char*)g.A + (size_t)nxt.pm * tstep : cA; const char* nB = has_next ? (const char*)g.Bt + (size_t)nxt.pn * tstep : cB;
        for (int t = 0; t < nt; t += 2) {
            if constexpr (MidT<Epi>::v > 0) { if (t == MidT<Epi>::v) E.mid(acc, cur, wr, wc); }
            const bool last = (t == nt - 2);
            const char* a1 = cA + (size_t)(t + 1) * kstep;
            const char* a2 = last ? nA : cA + (size_t)(t + 2) * kstep; const char* b2 = last ? nB : cB + (size_t)(t + 2) * kstep;
            const char* a3 = a2 + kstep; const char* b3 = b2 + kstep;
            if (last && has_next) S.a_ready(nxt);
            if constexpr (SP2) {
            PG8_LDB(B0, 0, 0); PG8_LDB(B1, 0, 1); PG8_SCHED; PG8_LDA(At, 0, 0); PG8_STAGE(PG8_SA(1, 1), a1 + hstep, voffA);
            PG8_WAIT_V(8); PG8_WAIT_L(0); PG8_BAR; PG8_MMA(0, 0, At, B0); PG8_MMA(0, 1, At, B1); PG8_BAR; PG8_SCHED;
            PG8_LDA(At, 0, 1); PG8_STAGE(PG8_SB(0, 0), b2, voffB); PG8_STAGE(PG8_SB(0, 1), b2 + hstep, voffB); PG8_STAGE(PG8_SA(0, 0), a2, voffA);
            PG8_WAIT_V(8); PG8_WAIT_L(0); PG8_BAR; PG8_MMA(1, 0, At, B0); PG8_MMA(1, 1, At, B1); PG8_BAR; PG8_SCHED;
            PG8_LDB(B0, 1, 0); PG8_LDB(B1, 1, 1); PG8_SCHED; PG8_LDA(At, 1, 0); PG8_STAGE(PG8_SA(0, 1), a2 + hstep, voffA);
            PG8_WAIT_V(8); PG8_WAIT_L(0); PG8_BAR; PG8_MMA(0, 0, At, B0); PG8_MMA(0, 1, At, B1); PG8_BAR; PG8_SCHED;
            PG8_LDA(At, 1, 1); PG8_STAGE(PG8_SB(1, 0), b3, voffB); PG8_STAGE(PG8_SB(1, 1), b3 + hstep, voffB); PG8_STAGE(PG8_SA(1, 0), a3, voffA);
            PG8_WAIT_V(8); PG8_WAIT_L(0); PG8_BAR; PG8_MMA(1, 0, At, B0); PG8_MMA(1, 1, At, B1); PG8_BAR; PG8_SCHED;
            } else {
            PG8_LDB(B0, 0, 0); PG8_SCHED; PG8_LDA(At, 0, 0); PG8_STAGE(PG8_SA(1, 1), a1 + hstep, voffA);
            PG8_WAIT_L(8); PG8_BAR; PG8_WAIT_L(0); PG8_MMA(0, 0, At, B0); PG8_BAR; PG8_SCHED;
            PG8_LDB(B1, 0, 1); PG8_STAGE(PG8_SB(0, 0), b2, voffB);
            PG8_BAR; PG8_WAIT_L(0); PG8_MMA(0, 1, At, B1); PG8_BAR;
            PG8_LDA(At, 0, 1); PG8_STAGE(PG8_SA(0, 0), a2, voffA);
            PG8_BAR; PG8_WAIT_L(0); PG8_MMA(1, 0, At, B0); PG8_BAR; PG8_SCHED;
            PG8_STAGE(PG8_SB(0, 1), b2 + hstep, voffB);
            PG8_WAIT_V(6); PG8_BAR; PG8_MMA(1, 1, At, B1); PG8_BAR;
            PG8_LDB(B0, 1, 0); PG8_SCHED; PG8_LDA(At, 1, 0); PG8_STAGE(PG8_SA(0, 1), a2 + hstep, voffA);
            PG8_WAIT_L(8); PG8_BAR; PG8_WAIT_L(0); PG8_MMA(0, 0, At, B0); PG8_BAR; PG8_SCHED;
            PG8_LDB(B1, 1, 1); PG8_STAGE(PG8_SB(1, 0), b3, voffB);
            PG8_BAR; PG8_WAIT_L(0); PG8_MMA(0, 1, At, B1); PG8_BAR;
            PG8_LDA(At, 1, 1); PG8_STAGE(PG8_SA(1, 0), a3, voffA);
            PG8_BAR; PG8_WAIT_L(0); PG8_MMA(1, 0, At, B0); PG8_BAR; PG8_SCHED;
            PG8_STAGE(PG8_SB(1, 1), b3 + hstep, voffB);
            PG8_WAIT_V(6); PG8_BAR; PG8_MMA(1, 1, At, B1); PG8_BAR;
            }
        }
        if constexpr (ALIGN_EPI) { if (wr == 0) PG8_BAR; }
        if constexpr (!Epi::AFTER_DRAIN) { E(acc, cur, wr, wc, fr, fq); S.done(cur); }
        if (!has_next) break;
#pragma unroll
        for (int a = 0; a < 2; ++a)
#pragma unroll
            for (int b = 0; b < 2; ++b)
#pragma unroll
                for (int m = 0; m < 4; ++m)
#pragma unroll
                    for (int n = 0; n < 2; ++n) acc[a][b][m][n] = (f32x4){0.f, 0.f, 0.f, 0.f};
        cur = nxt; cA = nA; cB = nB; ++ui;
        if constexpr (ALIGN_EPI) { if (wr == 1) PG8_BAR; }
    }
    PG8_WAIT_V(0);
    if constexpr (!ALIGN_EPI) { if (wr == 0) PG8_BAR; }
    PG8_BAR;
    if constexpr (Epi::AFTER_DRAIN) { E.fused(acc, cur, wr, wc, fr, fq, lds, wid, lane); S.done(cur); }
#undef PG8_SA
#undef PG8_SB
#undef PG8_STAGE
#undef PG8_LDA
#undef PG8_LDB
#undef PG8_MMA
#undef PG8_WAIT_V
#undef PG8_WAIT_L
#undef PG8_BAR
#undef PG8_SCHED
}
}

constexpr int BATCH = 8, SEQ = 4096, DM = 1024, DEPTH = 4, MTOK = BATCH * SEQ, DFF = 4096;
constexpr int NIN = 3584;
constexpr float NORM_EPS = 1e-6f;
constexpr float LOG2E = 1.4426950408889634f;
constexpr int NPHASE = 2 + 14 * DEPTH;
#ifndef ONLY
#define ONLY -1
#endif
#define PH_EN(n) (ONLY < 0 || ONLY == (n))
#ifndef DBG_FINAL_SRC
#define DBG_FINAL_SRC outp
#endif

#define LAS __attribute__((address_space(3)))
#define GAS __attribute__((address_space(1)))
template <class T> __device__ __forceinline__ T* as_global(T* p) { return (T*)(GAS T*)p; }
typedef unsigned short bf16;
typedef float f32x4 __attribute__((ext_vector_type(4)));
typedef float f32x2 __attribute__((ext_vector_type(2)));
typedef float f32x16 __attribute__((ext_vector_type(16)));
typedef short bf16x8 __attribute__((ext_vector_type(8)));
typedef short s16x4 __attribute__((ext_vector_type(4)));
typedef unsigned u32x4 __attribute__((ext_vector_type(4)));
typedef unsigned u32x2 __attribute__((ext_vector_type(2)));
typedef __bf16 bf16x2_t __attribute__((ext_vector_type(2)));

constexpr size_t MiB = 1u << 20;
constexpr size_t WS_CTL = 0, WS_MOD = 1 * MiB, WS_COS = 2 * MiB, WS_SIN = 4 * MiB, WS_SSQQ = 6 * MiB, WS_SSQKV = 6 * MiB + 512 * 1024, WS_KRR = 7 * MiB;
constexpr size_t WS_WIN = 9 * MiB, WS_WVNA = 16 * MiB, WS_WUQ = 17 * MiB, WS_WUK = 17 * MiB + 512 * 1024, WS_WUV = 17 * MiB + 768 * 1024;
constexpr size_t WS_WBR = 18 * MiB,        WS_WOUT = 20 * MiB, WS_WFF1 = 22 * MiB, WS_WFF2 = 30 * MiB;
constexpr size_t WS_H = 38 * MiB;
constexpr size_t WS_GATES = 102 * MiB;
constexpr size_t WS_QKNA = 230 * MiB;
constexpr size_t WS_MERGED = 230 * MiB;
constexpr size_t WS_OCAT = 38 * MiB;
constexpr size_t WS_VTNA = 294 * MiB;
constexpr size_t WS_CQ = 326 * MiB, WS_CKV = 342 * MiB;
constexpr size_t WS_ONA = 350 * MiB;
constexpr size_t WS_QMLA = 382 * MiB;
constexpr size_t WS_TMP = 382 * MiB;
constexpr size_t WS_KNOPE = 430 * MiB;
constexpr size_t WS_VTMLA = 462 * MiB;
constexpr size_t WS_U = 102 * MiB;
constexpr size_t WS_HM = 382 * MiB;
constexpr size_t WS_SSQX = 510 * MiB;
constexpr size_t WS_SWIN = 64 * 1024, WS_SWFF = 384 * 1024;
constexpr size_t WS_RSTDA = 640 * 1024, WS_RSTDM = 768 * 1024;
constexpr size_t WS_NEED = 512 * MiB;
constexpr int LDS_BYTES = 147456;

__device__ __forceinline__ unsigned pk2(float lo, float hi) { f32x2 v = {lo, hi}; bf16x2_t b = __builtin_convertvector(v, bf16x2_t); return __builtin_bit_cast(unsigned, b); }
__device__ __forceinline__ float bflo(unsigned w) { return __builtin_bit_cast(float, w << 16); }
__device__ __forceinline__ float bfhi(unsigned w) { return __builtin_bit_cast(float, w & 0xffff0000u); }
__device__ __forceinline__ void st8bf(bf16* p, f32x4 a, f32x4 b) { u32x4 w; w.x = pk2(a.x, a.y); w.y = pk2(a.z, a.w); w.z = pk2(b.x, b.y); w.w = pk2(b.z, b.w); *(u32x4*)p = w; }
template <int X> __device__ __forceinline__ float swz_xor(float v) { return __builtin_bit_cast(float, __builtin_amdgcn_ds_swizzle(__builtin_bit_cast(int, v), 0x1f | (X << 10))); }
__device__ __forceinline__ void swap32(float v, float& lo, float& hi) { float a = v, b = v;
    asm volatile("v_nop\n\tv_nop\n\tv_permlane32_swap_b32 %0, %1" : "+v"(a), "+v"(b)); lo = a; hi = b; }
__device__ __forceinline__ float sum32(float v) { float lo, hi; swap32(v, lo, hi); return lo + hi; }
__device__ __forceinline__ float max32(float v) { float lo, hi; swap32(v, lo, hi); return fmaxf(lo, hi); }
__device__ __forceinline__ float partner32(float v, bool lower) { float lo, hi; swap32(v, lo, hi); return lower ? hi : lo; }
__device__ __forceinline__ float wave_sum(float v) {
    v += swz_xor<1>(v); v += swz_xor<2>(v); v += swz_xor<4>(v); v += swz_xor<8>(v); v += swz_xor<16>(v); return sum32(v);
}
__device__ __forceinline__ int my_lane() { int l; asm volatile("v_mbcnt_lo_u32_b32 %0, -1, 0\n\tv_mbcnt_hi_u32_b32 %0, -1, %0" : "=v"(l)); return l; }
#define LDS_WAIT() asm volatile("s_waitcnt lgkmcnt(0)" ::: "memory")

__device__ __forceinline__ void rope8(f32x4& v0, f32x4& v1, const float* cosT, const float* sinT, int row, int fq) {
    f32x4 p0, p1;
    const bool lower = fq < 2;
    p0.x = partner32(v0.x, lower); p0.y = partner32(v0.y, lower); p0.z = partner32(v0.z, lower); p0.w = partner32(v0.w, lower);
    p1.x = partner32(v1.x, lower); p1.y = partner32(v1.y, lower); p1.z = partner32(v1.z, lower); p1.w = partner32(v1.w, lower);
    const int i0 = 8 * (fq & 1);
    const f32x4 c0 = *(const f32x4*)(cosT + (size_t)row * 16 + i0), c1 = *(const f32x4*)(cosT + (size_t)row * 16 + i0 + 4);
    const f32x4 s0 = *(const f32x4*)(sinT + (size_t)row * 16 + i0), s1 = *(const f32x4*)(sinT + (size_t)row * 16 + i0 + 4);
    if (fq < 2) { v0 = v0 * c0 - p0 * s0; v1 = v1 * c1 - p1 * s1; } else { v0 = v0 * c0 + p0 * s0; v1 = v1 * c1 + p1 * s1; }
}

__device__ __forceinline__ float rstd_x(const float* ssqx, int row) {
    const f32x4 a = *(const f32x4*)(ssqx + (size_t)row * 16), b = *(const f32x4*)(ssqx + (size_t)row * 16 + 4), c = *(const f32x4*)(ssqx + (size_t)row * 16 + 8), d = *(const f32x4*)(ssqx + (size_t)row * 16 + 12);
    const f32x4 t = (a + b) + (c + d);
    return __builtin_amdgcn_rsqf(((t.x + t.y) + (t.z + t.w)) * (1.f / 1024.f) + NORM_EPS);
}
__device__ __forceinline__ int gate_src(int g) { return ((g >> 7) & 1) * 1024 + (g >> 8) * 128 + (g & 127); }
__device__ __forceinline__ int in_origcol(int n) { return n < 1024 ? n : (n < 1440 ? n + 512 : (n < 1536 ? -1 : 1952 + gate_src(n - 1536))); }

#define EPI_ARGS const f32x4 (&acc)[2][2][4][2], const pg8::Unit& u, int wr, int wc, int fr_unused, int fq_unused
#define EPI_LANE const int ln_ = my_lane(); const int fr = ln_ & 15, fq = ln_ >> 4; (void)fr_unused; (void)fq_unused;
__device__ __forceinline__ bool epi_fence() { asm volatile("" ::: "memory"); return true; }
#define FOR_AI_M _Pragma("unroll") for (int ai = 0; ai < 2; ++ai) _Pragma("unroll") for (int m = 0; m < 4; ++m) if (epi_fence())
#define FOR_AI_M_NOFENCE _Pragma("unroll") for (int ai = 0; ai < 2; ++ai) _Pragma("unroll") for (int m = 0; m < 4; ++m)
#define LOAD_ROW_SCALARS(dst, ptr) float dst[2][4]; FOR_AI_M_NOFENCE dst[ai][m] = (ptr)[rbase + ai * 128 + m * 16];

struct EpiInProj {
    static constexpr bool PERM = true, AFTER_DRAIN = false;
    unsigned char* ws; const float* bgate; float qscale;
    __device__ __forceinline__ void operator()(EPI_ARGS) const {
        EPI_LANE
        bf16* const qk = (bf16*)(ws + WS_QKNA); bf16* const cq = (bf16*)(ws + WS_CQ); bf16* const ckv = (bf16*)(ws + WS_CKV); bf16* const krr = (bf16*)(ws + WS_KRR); bf16* const gates = (bf16*)(ws + WS_GATES);
        float* const ssq_q = (float*)(ws + WS_SSQQ); float* const ssq_kv = (float*)(ws + WS_SSQKV); const float* const cosT = (const float*)(ws + WS_COS); const float* const sinT = (const float*)(ws + WS_SIN);
        const int pn = u.pn; const int rbase = u.pm * 256 + wr * 64 + fr;
        const float* const swb = (const float*)(ws + WS_SWIN) + (size_t)((u.pm * 256) >> 12) * 4000;
        LOAD_ROW_SCALARS(rsv, (const float*)(ws + WS_RSTDA))
        f32x4 sb[2][2];
#pragma unroll
        for (int bj = 0; bj < 2; ++bj) { const int ob = in_origcol(pn * 256 + bj * 128 + wc * 32), oc = ob + fq * 8;
            if (ob >= 0) { sb[bj][0] = *(const f32x4*)(swb + oc) + *(const f32x4*)(swb + 32000 + oc); sb[bj][1] = *(const f32x4*)(swb + oc + 4) + *(const f32x4*)(swb + 32000 + oc + 4); } else { sb[bj][0] = (f32x4){0.f, 0.f, 0.f, 0.f}; sb[bj][1] = sb[bj][0]; } }
#define ACCN(ai, bj, m, n) (acc[ai][bj][m][n] * rs_ + sb[bj][n])
        if (pn < 4) {
            const float sc = pn < 2 ? qscale : 1.f;
            FOR_AI_M { const int row = rbase + ai * 128 + m * 16; const float rs_ = rsv[ai][m];
#pragma unroll
                for (int bj = 0; bj < 2; ++bj) st8bf(qk + (size_t)row * 1024 + pn * 256 + bj * 128 + wc * 32 + fq * 8, ACCN(ai, bj, m, 0) * sc, ACCN(ai, bj, m, 1) * sc); }
        } else if (pn == 4) {
            FOR_AI_M { const int row = rbase + ai * 128 + m * 16; const float rs_ = rsv[ai][m]; float s = 0.f;
                f32x4 v[2][2];
#pragma unroll
                for (int bj = 0; bj < 2; ++bj)
#pragma unroll
                    for (int n = 0; n < 2; ++n) { const f32x4 x = ACCN(ai, bj, m, n); v[bj][n] = x; s += (x.x * x.x + x.y * x.y) + (x.z * x.z + x.w * x.w); }
                s += swz_xor<16>(s); s = sum32(s);
                if (fq == 0) ssq_q[(size_t)row * 4 + wc] = s;
#pragma unroll
                for (int bj = 0; bj < 2; ++bj) st8bf(cq + (size_t)row * 256 + bj * 128 + wc * 32 + fq * 8, v[bj][0], v[bj][1]); }
        } else if (pn == 5) {
            FOR_AI_M { const int row = rbase + ai * 128 + m * 16; const float rs_ = rsv[ai][m]; float s = 0.f;
                const f32x4 k0 = ACCN(ai, 0, m, 0), k1 = ACCN(ai, 0, m, 1);
                s = (k0.x * k0.x + k0.y * k0.y) + (k0.z * k0.z + k0.w * k0.w) + (k1.x * k1.x + k1.y * k1.y) + (k1.z * k1.z + k1.w * k1.w);
                s += swz_xor<16>(s); s = sum32(s);
                if (fq == 0) ssq_kv[(size_t)row * 4 + wc] = s;
                st8bf(ckv + (size_t)row * 128 + wc * 32 + fq * 8, k0, k1);
                if (wc == 0) { f32x4 v0 = ACCN(ai, 1, m, 0), v1 = ACCN(ai, 1, m, 1); rope8(v0, v1, cosT, sinT, row, fq); st8bf(krr + (size_t)row * 32 + fq * 8, v0, v1); }
            }
        } else {
            const int oc = (pn - 6) * 128 + wc * 32 + fq * 8;
            const f32x4 bn0 = *(const f32x4*)(bgate + oc), bn1 = *(const f32x4*)(bgate + oc + 4), bm0 = *(const f32x4*)(bgate + 1024 + oc), bm1 = *(const f32x4*)(bgate + 1024 + oc + 4);
            FOR_AI_M { const int row = rbase + ai * 128 + m * 16; const float rs_ = rsv[ai][m];
                f32x4 n0 = ACCN(ai, 0, m, 0) + bn0, n1 = ACCN(ai, 0, m, 1) + bn1, m0 = ACCN(ai, 1, m, 0) + bm0, m1 = ACCN(ai, 1, m, 1) + bm1;
#pragma unroll
                for (int j = 0; j < 4; ++j) {
                    const float en0 = __builtin_amdgcn_exp2f(-LOG2E * n0[j]), en1 = __builtin_amdgcn_exp2f(-LOG2E * n1[j]), em0 = __builtin_amdgcn_exp2f(-LOG2E * m0[j]), em1 = __builtin_amdgcn_exp2f(-LOG2E * m1[j]);
                    m0[j] = fmaxf(__builtin_amdgcn_rcpf(1.f + em0), 1e-18f); m1[j] = fmaxf(__builtin_amdgcn_rcpf(1.f + em1), 1e-18f);
                    n0[j] = __builtin_amdgcn_rcpf(1.f + en0) * __builtin_amdgcn_rcpf(m0[j]); n1[j] = __builtin_amdgcn_rcpf(1.f + en1) * __builtin_amdgcn_rcpf(m1[j]); }
                st8bf(gates + (size_t)row * 2048 + oc, n0, n1); st8bf(gates + (size_t)row * 2048 + 1024 + oc, m0, m1); }
        }
    }
};
#undef ACCN
struct EpiVtNa {
    static constexpr bool PERM = true, AFTER_DRAIN = false;
    unsigned char* ws;
    __device__ __forceinline__ void operator()(EPI_ARGS) const {
        EPI_LANE
        bf16* const O = (bf16*)(ws + WS_VTNA); const float* const rstd = (const float*)(ws + WS_RSTDA);
        const int rbase = u.pm * 256 + wr * 64 + fr, cbase = u.pn * 256 + wc * 32 + fq * 8;
        const float* const swb = (const float*)(ws + WS_SWIN) + (size_t)((u.pn * 256) >> 12) * 4000 + 1024;
        LOAD_ROW_SCALARS(sb0, swb) LOAD_ROW_SCALARS(sb1, swb + 32000)
        f32x4 rr[2][2];
#pragma unroll
        for (int bj = 0; bj < 2; ++bj) { rr[bj][0] = *(const f32x4*)(rstd + cbase + bj * 128); rr[bj][1] = *(const f32x4*)(rstd + cbase + bj * 128 + 4); }
        FOR_AI_M { const int row = rbase + ai * 128 + m * 16; const float sbv = sb0[ai][m] + sb1[ai][m];
#pragma unroll
            for (int bj = 0; bj < 2; ++bj) st8bf(O + (size_t)row * MTOK + cbase + bj * 128, acc[ai][bj][m][0] * rr[bj][0] + sbv, acc[ai][bj][m][1] * rr[bj][1] + sbv); }
    }
};

struct EpiQup {
    static constexpr bool PERM = true, AFTER_DRAIN = false;
    unsigned char* ws; float scale;
    __device__ __forceinline__ void operator()(EPI_ARGS) const {
        EPI_LANE
        bf16* const Q = (bf16*)(ws + WS_QMLA); const float* const ssq = (const float*)(ws + WS_SSQQ); const float* const cosT = (const float*)(ws + WS_COS); const float* const sinT = (const float*)(ws + WS_SIN);
        const int rbase = u.pm * 256 + wr * 64 + fr;
        float rsv[2][4];
#pragma unroll
        for (int ai = 0; ai < 2; ++ai) { f32x4 pp[4];
#pragma unroll
            for (int m = 0; m < 4; ++m) pp[m] = *(const f32x4*)(ssq + (size_t)(rbase + ai * 128 + m * 16) * 4);
#pragma unroll
            for (int m = 0; m < 4; ++m) rsv[ai][m] = __builtin_amdgcn_rsqf(((pp[m].x + pp[m].y) + (pp[m].z + pp[m].w)) * (1.f / 256.f) + NORM_EPS) * scale;
            epi_fence(); }
        FOR_AI_M { const int row = rbase + ai * 128 + m * 16;
            const float rs = rsv[ai][m];
#pragma unroll
            for (int bj = 0; bj < 2; ++bj) { const int g = u.pn * 8 + bj * 4 + wc; f32x4 v0 = acc[ai][bj][m][0] * rs, v1 = acc[ai][bj][m][1] * rs;
                if (g % 3 == 2) rope8(v0, v1, cosT, sinT, row, fq);
                st8bf(Q + (size_t)row * 768 + g * 32 + fq * 8, v0, v1); } }
    }
};

struct EpiKup {
    static constexpr bool PERM = true, AFTER_DRAIN = false;
    unsigned char* ws;
    __device__ __forceinline__ void operator()(EPI_ARGS) const {
        EPI_LANE
        bf16* const Kn = (bf16*)(ws + WS_KNOPE); const float* const ssq = (const float*)(ws + WS_SSQKV);
        const int rbase = u.pm * 256 + wr * 64 + fr, cbase = u.pn * 256 + wc * 32 + fq * 8;
        float rsv[2][4];
#pragma unroll
        for (int ai = 0; ai < 2; ++ai) { f32x4 pp[4];
#pragma unroll
            for (int m = 0; m < 4; ++m) pp[m] = *(const f32x4*)(ssq + (size_t)(rbase + ai * 128 + m * 16) * 4);
#pragma unroll
            for (int m = 0; m < 4; ++m) rsv[ai][m] = __builtin_amdgcn_rsqf(((pp[m].x + pp[m].y) + (pp[m].z + pp[m].w)) * (1.f / 128.f) + NORM_EPS);
            epi_fence(); }
        FOR_AI_M { const int row = rbase + ai * 128 + m * 16;
            const float rs = rsv[ai][m];
#pragma unroll
            for (int bj = 0; bj < 2; ++bj) st8bf(Kn + (size_t)row * 512 + cbase + bj * 128, acc[ai][bj][m][0] * rs, acc[ai][bj][m][1] * rs); }
    }
};

struct EpiVtUp {
    static constexpr bool PERM = true, AFTER_DRAIN = false;
    unsigned char* ws;
    __device__ __forceinline__ void operator()(EPI_ARGS) const {
        EPI_LANE
        bf16* const Vt = (bf16*)(ws + WS_VTMLA); const float* const ssq = (const float*)(ws + WS_SSQKV);
        const int rbase = u.pm * 256 + wr * 64 + fr, cbase = u.pn * 256 + wc * 32 + fq * 8;
#pragma unroll
        for (int bj = 0; bj < 2; ++bj) {
            f32x4 r0, r1;
#pragma unroll
            for (int j = 0; j < 4; ++j) { const f32x4 p = *(const f32x4*)(ssq + (size_t)(cbase + bj * 128 + j) * 4), q = *(const f32x4*)(ssq + (size_t)(cbase + bj * 128 + 4 + j) * 4);
                r0[j] = __builtin_amdgcn_rsqf(((p.x + p.y) + (p.z + p.w)) * (1.f / 128.f) + NORM_EPS); r1[j] = __builtin_amdgcn_rsqf(((q.x + q.y) + (q.z + q.w)) * (1.f / 128.f) + NORM_EPS); }
            FOR_AI_M { const int row = rbase + ai * 128 + m * 16; st8bf(Vt + (size_t)row * MTOK + cbase + bj * 128, acc[ai][bj][m][0] * r0, acc[ai][bj][m][1] * r1); }
        }
    }
};

struct EpiBr {
    static constexpr bool PERM = true, AFTER_DRAIN = false; static constexpr int MID_T = 8;
    unsigned char* ws;
    __device__ __forceinline__ void mid(f32x4 (&acc)[2][2][4][2], const pg8::Unit& u, int wr, int wc) const {
        const int ln_ = my_lane(); const int fr = ln_ & 15, fq = ln_ >> 4;
        const bf16* const gates = (const bf16*)(ws + WS_GATES);
        const int rbase = u.pm * 256 + wr * 64 + fr, cbase = u.pn * 256 + wc * 32 + fq * 8;
#pragma unroll
        for (int ai = 0; ai < 2; ++ai) {
            u32x4 ga[4][2];
#pragma unroll
            for (int m = 0; m < 4; ++m)
#pragma unroll
                for (int bj = 0; bj < 2; ++bj) ga[m][bj] = *(const u32x4*)(gates + (size_t)(rbase + ai * 128 + m * 16) * 2048 + cbase + bj * 128);
            epi_fence();
#pragma unroll
            for (int m = 0; m < 4; ++m)
#pragma unroll
                for (int bj = 0; bj < 2; ++bj) { const u32x4 a = ga[m][bj];
                    const f32x4 n0 = {bflo(a.x), bfhi(a.x), bflo(a.y), bfhi(a.y)}, n1 = {bflo(a.z), bfhi(a.z), bflo(a.w), bfhi(a.w)};
                    acc[ai][bj][m][0] = acc[ai][bj][m][0] * n0; acc[ai][bj][m][1] = acc[ai][bj][m][1] * n1; }
        }
    }
    __device__ __forceinline__ void operator()(EPI_ARGS) const {
        EPI_LANE
        const bf16* const gates = (const bf16*)(ws + WS_GATES); bf16* const merged = (bf16*)(ws + WS_MERGED);
        const int rbase = u.pm * 256 + wr * 64 + fr, cbase = u.pn * 256 + wc * 32 + fq * 8;
#pragma unroll
        for (int ai = 0; ai < 2; ++ai) {
            u32x4 gb[4][2];
#pragma unroll
            for (int m = 0; m < 4; ++m)
#pragma unroll
                for (int bj = 0; bj < 2; ++bj) gb[m][bj] = *(const u32x4*)(gates + (size_t)(rbase + ai * 128 + m * 16) * 2048 + 1024 + cbase + bj * 128);
            epi_fence();
#pragma unroll
            for (int m = 0; m < 4; ++m)
#pragma unroll
                for (int bj = 0; bj < 2; ++bj) { const u32x4 b = gb[m][bj];
                    f32x4 m0 = {bflo(b.x), bfhi(b.x), bflo(b.y), bfhi(b.y)}, m1 = {bflo(b.z), bfhi(b.z), bflo(b.w), bfhi(b.w)};
#pragma unroll
                    for (int j = 0; j < 4; ++j) { m0[j] = fmaxf(m0[j], 1e-18f); m1[j] = fmaxf(m1[j], 1e-18f); }
                    st8bf(merged + (size_t)(rbase + ai * 128 + m * 16) * 1024 + cbase + bj * 128, acc[ai][bj][m][0] * m0, acc[ai][bj][m][1] * m1); }
        }
    }
};
template <int RES_ROWS>
struct EpiResid {
    static constexpr bool PERM = true, AFTER_DRAIN = false;
    const float* xres; float* out; const float* gate;
    bf16* Hn; const float* gn; const float* scn; float* ssqx;
    __device__ __forceinline__ void operator()(EPI_ARGS) const {
        EPI_LANE
        const int rbase = u.pm * 256 + wr * 64 + fr, cbase = u.pn * 256 + wc * 32 + fq * 8;
        const int bb = (u.pm * 256) >> 12;
        const float* gb = gate + (size_t)bb * 6144;
        f32x4 g[2][2], Gm[2][2];
#pragma unroll
        for (int bj = 0; bj < 2; ++bj) { const int col = cbase + bj * 128; g[bj][0] = *(const f32x4*)(gb + col); g[bj][1] = *(const f32x4*)(gb + col + 4);
            Gm[bj][0] = (f32x4){0.f, 0.f, 0.f, 0.f}; Gm[bj][1] = Gm[bj][0];
            if (Hn) { const float* sp = scn + (size_t)bb * 6144 + col; Gm[bj][0] = *(const f32x4*)(gn + col) * (*(const f32x4*)sp + 1.f); Gm[bj][1] = *(const f32x4*)(gn + col + 4) * (*(const f32x4*)(sp + 4) + 1.f); } }
#pragma unroll
        for (int ai = 0; ai < 2; ++ai)
#pragma unroll
        for (int mh = 0; mh < 4; mh += RES_ROWS) {
            f32x4 xr[4][2][2];
#pragma unroll
            for (int m = mh; m < mh + RES_ROWS; ++m)
#pragma unroll
                for (int bj = 0; bj < 2; ++bj) { const float* xp = xres + (size_t)(rbase + ai * 128 + m * 16) * 1024 + cbase + bj * 128; xr[m][bj][0] = *(const f32x4*)xp; xr[m][bj][1] = *(const f32x4*)(xp + 4); }
            epi_fence();
#pragma unroll
            for (int m = mh; m < mh + RES_ROWS; ++m) { const int row = rbase + ai * 128 + m * 16; float sv = 0.f;
#pragma unroll
                for (int bj = 0; bj < 2; ++bj) { const size_t o = (size_t)row * 1024 + cbase + bj * 128;
                    const f32x4 x0 = xr[m][bj][0] + g[bj][0] * acc[ai][bj][m][0], x1 = xr[m][bj][1] + g[bj][1] * acc[ai][bj][m][1];
                    *(f32x4*)(out + o) = x0; *(f32x4*)(out + o + 4) = x1;
                    if (Hn) { st8bf(Hn + o, x0 * Gm[bj][0], x1 * Gm[bj][1]);
                        sv += (x0.x * x0.x + x0.y * x0.y) + (x0.z * x0.z + x0.w * x0.w) + (x1.x * x1.x + x1.y * x1.y) + (x1.z * x1.z + x1.w * x1.w); } }
                if (Hn) { sv += swz_xor<16>(sv); sv = sum32(sv); if (fq == 0) ssqx[(size_t)row * 16 + u.pn * 4 + wc] = sv; } }
        }
    }
};
struct EpiFF1 {
    static constexpr bool PERM = true, AFTER_DRAIN = false;
    unsigned char* ws;
    __device__ __forceinline__ void operator()(EPI_ARGS) const {
        EPI_LANE
        bf16* const U = (bf16*)(ws + WS_U);
        const int rbase = u.pm * 256 + wr * 64 + fr, cbase = u.pn * 256 + wc * 32 + fq * 8;
        LOAD_ROW_SCALARS(rsv, (const float*)(ws + WS_RSTDM))
        const float* const swb = (const float*)(ws + WS_SWFF) + (size_t)((u.pm * 256) >> 12) * 4096 + cbase;
        f32x4 sb[2][2];
#pragma unroll
        for (int bj = 0; bj < 2; ++bj) { sb[bj][0] = *(const f32x4*)(swb + bj * 128) + *(const f32x4*)(swb + 32768 + bj * 128); sb[bj][1] = *(const f32x4*)(swb + bj * 128 + 4) + *(const f32x4*)(swb + 32768 + bj * 128 + 4); }
        FOR_AI_M { const int row = rbase + ai * 128 + m * 16; const float rs_ = rsv[ai][m];
#pragma unroll
            for (int bj = 0; bj < 2; ++bj) { f32x4 v0 = acc[ai][bj][m][0] * rs_ + sb[bj][0], v1 = acc[ai][bj][m][1] * rs_ + sb[bj][1];
#pragma unroll
                for (int j = 0; j < 4; ++j) { const float a = fmaxf(v0[j], 0.f), b = fmaxf(v1[j], 0.f); v0[j] = a * a; v1[j] = b * b; }
                st8bf(U + (size_t)row * DFF + cbase + bj * 128, v0, v1); } }
    }
};

template <class Epi>
__device__ __forceinline__ void run_gemm(LAS unsigned char* lds, int wave0, int bid, int G, const bf16* A, const bf16* Bt, int Mr, int Nc, int K, const Epi& E) {
    { GAS const bf16* Ag = (GAS const bf16*)A; GAS const bf16* Bg = (GAS const bf16*)Bt; asm volatile("" : "+s"(Ag), "+s"(Bg)); A = (const bf16*)Ag; Bt = (const bf16*)Bg; }
    pg8::Gemm g{A, Bt, Mr, Nc, K}; pg8::StaticOrder S; S.init(Mr, Nc, G, bid);
    pg8::gemm_phase<Epi, pg8::StaticOrder, true, true>((PG8_LAS unsigned char*)lds, wave0, g, S, E);
}

__device__ __forceinline__ void conv_item(const float* W, int K, int N, int col0, const float* g, bf16* WT, int row0, int k0, LAS float* scr, int lane, int pitch, int kd) {
    f32x4 v[8];
    const int kr = lane >> 3, n4 = (lane & 7) * 4;
#pragma unroll
    for (int i = 0; i < 8; ++i) v[i] = (col0 >= 0) ? *(const f32x4*)(W + (size_t)(k0 + 8 * i + kr) * N + col0 + n4) : (f32x4){0.f, 0.f, 0.f, 0.f};
    if (g) {
#pragma unroll
        for (int i = 0; i < 8; ++i) v[i] = v[i] * g[k0 + 8 * i + kr];
    }
#pragma unroll
    for (int i = 0; i < 8; ++i) { LAS float* d = scr + (8 * i + kr) * 33 + n4; d[0] = v[i].x; d[1] = v[i].y; d[2] = v[i].z; d[3] = v[i].w; }
    LDS_WAIT();
    const int c = lane & 7;
#pragma unroll
    for (int j = 0; j < 4; ++j) { const int n = (lane >> 3) + 8 * j; const LAS float* s = scr + (8 * c) * 33 + n;
        u32x4 o; o.x = pk2(s[0 * 33], s[1 * 33]); o.y = pk2(s[2 * 33], s[3 * 33]); o.z = pk2(s[4 * 33], s[5 * 33]); o.w = pk2(s[6 * 33], s[7 * 33]);
        *(u32x4*)(WT + (size_t)(row0 + n) * pitch + kd + k0 + 8 * c) = o; }
    LDS_WAIT();
}
__device__ __forceinline__ int conv_map(int kind, int n0, int off) {
    if (kind == 0) return n0 + off;
    if (kind == 1) return n0 < 1024 ? n0 : (n0 < 1440 ? n0 + 512 : (n0 < 1536 ? -1 : 1952 + ((((n0 - 1536) >> 7) & 1) * 1024 + ((n0 - 1536) >> 8) * 128 + ((n0 - 1536) & 127))));
    if (kind == 2) return (n0 >> 6) * 128 + (n0 & 63);
    return (n0 >> 6) * 128 + 64 + (n0 & 63);
}

struct Args { const void* in[20]; float* out; unsigned char* ws; int ph_lo, ph_hi; };
typedef const __attribute__((address_space(4))) Args* ArgsP;

__device__ __forceinline__ void phase_convert(ArgsP ap, int l, LAS unsigned char* lds, int gw, int NGW, int wave, int lane) {
    LAS float* scr = (LAS float*)(lds + wave * 8704);
    unsigned char* ws = as_global(ap->ws);
    const float* w_in = as_global((const float*)ap->in[6]) + (size_t)l * 1024 * 4000;
    const float* g_q = as_global((const float*)ap->in[9]) + l * 256;   const float* w_uq = as_global((const float*)ap->in[10]) + (size_t)l * 256 * 768;
    const float* g_kv = as_global((const float*)ap->in[11]) + l * 128; const float* w_ukv = as_global((const float*)ap->in[12]) + (size_t)l * 128 * 1024;
    const float* w_bn = as_global((const float*)ap->in[13]) + (size_t)l * 512 * 1024; const float* w_bm = as_global((const float*)ap->in[14]) + (size_t)l * 512 * 1024;
    const float* w_o = as_global((const float*)ap->in[15]) + (size_t)l * 1024 * 1024;
    const float* w_1 = as_global((const float*)ap->in[17]) + (size_t)l * 1024 * 4096; const float* w_2 = as_global((const float*)ap->in[18]) + (size_t)l * 4096 * 1024;
    constexpr int NITEMS = 16 * 112 + 16 * 16 + 4 * 24 + 2 * 16 + 2 * 16 + 8 * 32 + 8 * 32 + 16 * 32 + 16 * 128 + 64 * 32;
    for (int it = gw; it < NITEMS; it += NGW) {
        int r = it;
#define CONV_JOB(Wp, Kk, Nn, ndst, kind, off, gp, WTp) CONV_JOB2(Wp, Kk, Nn, ndst, kind, off, gp, WTp, Kk, 0)
#define CONV_JOB2(Wp, Kk, Nn, ndst, kind, off, gp, WTp, pitch_, kd_) { constexpr int nb_ = (ndst) / 32, cnt_ = ((Kk) / 64) * nb_; \
            if (r < cnt_) { const int kb_ = r / nb_, n0_ = (r % nb_) * 32; conv_item(Wp, Kk, Nn, conv_map(kind, n0_, off), gp, (bf16*)(ws + WTp), n0_, kb_ * 64, scr, lane, pitch_, kd_); continue; } r -= cnt_; }
        CONV_JOB(w_in, 1024, 4000, NIN, 1, 0, (const float*)nullptr, WS_WIN)
        CONV_JOB(w_in, 1024, 4000, 512, 0, 1024, (const float*)nullptr, WS_WVNA)
        CONV_JOB(w_uq, 256, 768, 768, 0, 0, g_q, WS_WUQ)
        CONV_JOB(w_ukv, 128, 1024, 512, 2, 0, g_kv, WS_WUK)
        CONV_JOB(w_ukv, 128, 1024, 512, 3, 0, g_kv, WS_WUV)
        CONV_JOB2(w_bn, 512, 1024, 1024, 0, 0, (const float*)nullptr, WS_WBR, 1024, 0)
        CONV_JOB2(w_bm, 512, 1024, 1024, 0, 0, (const float*)nullptr, WS_WBR, 1024, 512)
        CONV_JOB(w_o, 1024, 1024, 1024, 0, 0, (const float*)nullptr, WS_WOUT)
        CONV_JOB(w_1, 1024, 4096, 4096, 0, 0, (const float*)nullptr, WS_WFF1)
        CONV_JOB(w_2, 4096, 1024, 1024, 0, 0, (const float*)nullptr, WS_WFF2)
#undef CONV_JOB
#undef CONV_JOB2
    }
}

__device__ __forceinline__ void phase_rstd(const float* ssqx, float* rstd, int tid, int bid, int G) {
    for (int row = bid * 512 + tid; row < MTOK; row += G * 512) rstd[row] = rstd_x(ssqx, row);
}
__device__ __forceinline__ void phase_xg(const float* x, const float* g, const float* modl, int scale_off, bf16* h, float* rstd, int gw, int NGW, int lane) {
    for (int row = gw; row < MTOK; row += NGW) {
        const f32x4* xr = (const f32x4*)(x + (size_t)row * DM) + lane;
        f32x4 v[4]; float s = 0.f;
#pragma unroll
        for (int j = 0; j < 4; ++j) { v[j] = xr[64 * j]; s += (v[j].x * v[j].x + v[j].y * v[j].y) + (v[j].z * v[j].z + v[j].w * v[j].w); }
        s = wave_sum(s);
        if (lane == 0) rstd[row] = __builtin_amdgcn_rsqf(s * (1.f / 1024.f) + NORM_EPS);
        const float* mb = modl + (size_t)(row >> 12) * 6144;
#pragma unroll
        for (int j = 0; j < 4; ++j) { const int col = 256 * j + 4 * lane;
            const f32x4 gg = *(const f32x4*)(g + col), sc = *(const f32x4*)(mb + scale_off + col);
            const f32x4 y = v[j] * gg * (sc + 1.f);
            u32x2 o; o.x = pk2(y.x, y.y); o.y = pk2(y.z, y.w); *(u32x2*)(h + (size_t)row * DM + col) = o; }
    }
}
__device__ __forceinline__ void phase_sw(const float* w_in, const float* w_ff1, const float* modl, float* swin, float* swff, LAS unsigned char* lds, int tid, int bid, int G) {
    LAS float* sh = (LAS float*)lds;
    LAS float* red = (LAS float*)(lds + 65536);
    for (int i = tid; i < 16384; i += 512) { const int w = i >> 13, b = (i >> 10) & 7, k = i & 1023; sh[i] = modl[(size_t)b * 6144 + (w ? 3072 : 0) + k]; }
    __syncthreads();
    const int kg = tid >> 6, jl = tid & 63;
    for (int it2 = bid; it2 < 2 * (63 + 64); it2 += G) {
        const int item = it2 >> 1, kh = it2 & 1;
        const bool ff = item >= 63; const int j0 = (ff ? item - 63 : item) * 64, N = ff ? 4096 : 4000;
        const float* W = ff ? w_ff1 : w_in; const LAS float* shp = sh + (ff ? 8192 : 0) + kh * 512 + kg * 64;
        const bool colok = j0 + jl < N;
        float acc[8];
#pragma unroll
        for (int b = 0; b < 8; ++b) acc[b] = 0.f;
        const float* wp = W + (size_t)(kh * 512 + kg * 64) * N + j0 + (colok ? jl : 0);
#pragma unroll
        for (int k0 = 0; k0 < 64; k0 += 16) {
            float w[16];
#pragma unroll
            for (int q = 0; q < 16; ++q) w[q] = wp[(size_t)(k0 + q) * N];
#pragma unroll
            for (int q = 0; q < 16; ++q)
#pragma unroll
                for (int b = 0; b < 8; ++b) acc[b] += shp[b * 1024 + k0 + q] * w[q];
        }
#pragma unroll
        for (int b = 0; b < 8; ++b) red[(kg * 64 + jl) * 8 + b] = acc[b];
        __syncthreads();
        { const int b = tid >> 6; float sv = 0.f;
#pragma unroll
          for (int k2 = 0; k2 < 8; ++k2) sv += red[(k2 * 64 + jl) * 8 + b];
          if (colok) (ff ? swff : swin)[(size_t)(kh * 8 + b) * N + j0 + jl] = sv; }
        __syncthreads();
    }
}
__device__ __forceinline__ void phase_final_norm(float* x, const float* g, int gw, int NGW, int lane, const float* xsrc, const float* xalt) {
    constexpr int RB = 4;
    for (int row0 = gw; row0 < MTOK; row0 += RB * NGW) {
        f32x4 v[RB][4]; float rs[RB];
#pragma unroll
        for (int q = 0; q < RB; ++q) { const int row = row0 + q * NGW;
            const f32x4* xs = (const f32x4*)(xsrc + (size_t)(row < MTOK ? row : row0) * DM) + lane;
#pragma unroll
            for (int j = 0; j < 4; ++j) v[q][j] = xs[64 * j]; }
#pragma unroll
        for (int q = 0; q < RB; ++q) { float s = 0.f;
#pragma unroll
            for (int j = 0; j < 4; ++j) s += (v[q][j].x * v[q][j].x + v[q][j].y * v[q][j].y) + (v[q][j].z * v[q][j].z + v[q][j].w * v[q][j].w);
            rs[q] = 1.f / sqrtf(wave_sum(s) * (1.f / DM) + NORM_EPS); }
#pragma unroll
        for (int q = 0; q < RB; ++q) { const int row = row0 + q * NGW;
            if (row < MTOK) { f32x4* xr = (f32x4*)(x + (size_t)row * DM) + lane;
#pragma unroll
                for (int j = 0; j < 4; ++j) { const f32x4 gg = *(const f32x4*)(g + 256 * j + 4 * lane); xr[64 * j] = v[q][j] * rs[q] * gg; } } }
    }
    (void)xalt;
}

__device__ __forceinline__ void phase_p0(ArgsP ap, LAS unsigned char* lds, int tid, int bid, int G) {
    const float* c = as_global((const float*)ap->in[1]); const int* pos = as_global((const int*)ap->in[2]);
    const float* w_ada = as_global((const float*)ap->in[3]); const float* b_ada = as_global((const float*)ap->in[4]);
    unsigned char* wsb = as_global(ap->ws); float* mod = (float*)(wsb + WS_MOD); float* cosT = (float*)(wsb + WS_COS); float* sinT = (float*)(wsb + WS_SIN);
    for (int idx = bid * 512 + tid; idx < MTOK * 16; idx += G * 512) {
        const int row = idx >> 4, i = idx & 15;
        const float inv = __builtin_amdgcn_exp2f(-(float)i * 0.830482023721841f);
        const float ang = (float)pos[row] * inv;
        double t = (double)ang * 0.15915494309189533577; t -= rint(t);
        const float tf = (float)t;
        cosT[idx] = __builtin_amdgcn_cosf(tf); sinT[idx] = __builtin_amdgcn_sinf(tf);
    }
    LAS float* sc = (LAS float*)lds;
    LAS float* red = (LAS float*)(lds + 32768);
    for (int i = tid; i < 8192; i += 512) { const float v = c[i]; sc[i] = v / (1.f + __expf(-v)); }
    __syncthreads();
    const int kg = tid >> 6, jl = tid & 63;
    for (int item = bid; item < DEPTH * 96; item += G) {
        const int l = item / 96, j0 = (item % 96) * 64;
        float acc[8];
#pragma unroll
        for (int b = 0; b < 8; ++b) acc[b] = 0.f;
        const float* wp = w_ada + ((size_t)l * 1024 + kg * 128) * 6144 + j0 + jl;
#pragma unroll 1
        for (int k0 = 0; k0 < 128; k0 += 16) {
            float w[16];
#pragma unroll
            for (int q = 0; q < 16; ++q) w[q] = wp[(size_t)(k0 + q) * 6144];
#pragma unroll
            for (int q = 0; q < 16; ++q)
#pragma unroll
                for (int b = 0; b < 8; ++b) acc[b] += sc[b * 1024 + kg * 128 + k0 + q] * w[q];
        }
#pragma unroll
        for (int b = 0; b < 8; ++b) red[(kg * 64 + jl) * 8 + b] = acc[b];
        __syncthreads();
        { const int b = tid >> 6; float s = b_ada[l * 6144 + j0 + jl];
#pragma unroll
          for (int k2 = 0; k2 < 8; ++k2) s += red[(k2 * 64 + jl) * 8 + b];
          mod[((size_t)l * 8 + b) * 6144 + j0 + jl] = s; }
        __syncthreads();
    }
}

#define MFMA32(a, b, c) __builtin_amdgcn_mfma_f32_32x32x16_bf16((a), (b), (c), 0, 0, 0)
__device__ __forceinline__ bf16x8 pack8(const f32x16& x, int s) {
    u32x4 p; p.x = pk2(x[8 * s], x[8 * s + 1]); p.y = pk2(x[8 * s + 2], x[8 * s + 3]); p.z = pk2(x[8 * s + 4], x[8 * s + 5]); p.w = pk2(x[8 * s + 6], x[8 * s + 7]);
    return __builtin_bit_cast(bf16x8, p);
}
__device__ __forceinline__ f32x16 zero16() { f32x16 z;
#pragma unroll
    for (int i = 0; i < 16; ++i) z[i] = 0.f;
    return z; }

constexpr int MLA_KP = 208, MLA_VP = 144, MLA_VOFF = 64 * MLA_KP, MLA_BUF = MLA_VOFF + 64 * MLA_VP;
__device__ __forceinline__ void phase_mla(const bf16* Q, const bf16* Kn, const bf16* krr, const bf16* Vt, bf16* O, LAS unsigned char* lds, int tid, int wave, int lane, int bid, int G) {
    const int r = lane & 31, hh = lane >> 5;
    for (int unit = bid; unit < BATCH * 8 * 16; unit += G) {
        int qb = unit & 15, bh = unit >> 4;
        if (G == 256) { const int w = unit & 255, xcd = w & 7, slot = w >> 3; bh = (unit >> 8) * 16 + xcd * 2 + (slot >> 4); qb = slot & 15; }
        const int b = bh >> 3, h = bh & 7;
        const int tok0 = b * SEQ, q0 = tok0 + qb * 256 + wave * 32;
        bf16x8 qf[6];
#pragma unroll
        for (int s = 0; s < 6; ++s) qf[s] = *(const bf16x8*)(Q + (size_t)(q0 + r) * 768 + h * 96 + 16 * s + 8 * hh);
        f32x16 o0 = zero16(), o1 = zero16(); float mrun = 0.f, lrun = 0.f;
        f32x16 negm = zero16();
        const bf16* gA = Kn + (size_t)(tok0 + (tid >> 3)) * 512 + h * 64 + (tid & 7) * 8;   const int dA = (tid >> 3) * MLA_KP + (tid & 7) * 16;
        const bf16* gB = krr + (size_t)(tok0 + (tid >> 3)) * 32 + (tid & 7) * 4;               const int dB = (tid >> 3) * MLA_KP + 128 + (tid & 7) * 8;
        const bf16* gV = Vt + (size_t)(h * 64 + (tid >> 3)) * MTOK + tok0 + (tid & 7) * 8;    const int dV = MLA_VOFF + (tid >> 3) * MLA_VP + (16 * ((tid & 7) >> 1) + 4 * (tid & 1)) * 2;
        u32x4 ra, rv; u32x2 rb;
        ra = *(const u32x4*)gA; rv = *(const u32x4*)gV; rb = *(const u32x2*)gB;
        *(LAS u32x4*)(lds + dA) = ra; *(LAS u32x2*)(lds + dB) = rb;
        *(LAS u32x2*)(lds + dV) = (u32x2){rv.x, rv.y}; *(LAS u32x2*)(lds + dV + 16) = (u32x2){rv.z, rv.w};
        ra = *(const u32x4*)(gA + (size_t)64 * 512); rv = *(const u32x4*)(gV + 64); rb = *(const u32x2*)(gB + (size_t)64 * 32);
        __syncthreads();
        for (int kt = 0; kt < SEQ / 64; ++kt) {
            const int cur = kt & 1; LAS unsigned char* Kb = lds + cur * MLA_BUF; LAS unsigned char* Vb = Kb + MLA_VOFF;
            const bool more = kt + 1 < SEQ / 64;
            if (more) { LAS unsigned char* nb = lds + (cur ^ 1) * MLA_BUF;
                *(LAS u32x4*)(nb + dA) = ra; *(LAS u32x2*)(nb + dB) = rb;
                *(LAS u32x2*)(nb + dV) = (u32x2){rv.x, rv.y}; *(LAS u32x2*)(nb + dV + 16) = (u32x2){rv.z, rv.w}; }
            { const int t2 = kt + 2 < SEQ / 64 ? kt + 2 : SEQ / 64 - 1;
              ra = *(const u32x4*)(gA + (size_t)t2 * 64 * 512); rv = *(const u32x4*)(gV + t2 * 64); rb = *(const u32x2*)(gB + (size_t)t2 * 64 * 32); }
            f32x16 s0, s1;
#pragma unroll
            for (int s = 0; s < 6; ++s) {
                const bf16x8 k0 = *(const LAS bf16x8*)(Kb + r * MLA_KP + (16 * s + 8 * hh) * 2);
                const bf16x8 k1 = *(const LAS bf16x8*)(Kb + (32 + r) * MLA_KP + (16 * s + 8 * hh) * 2);
                if (s == 0) { s0 = MFMA32(k0, qf[0], negm); s1 = MFMA32(k1, qf[0], negm); } else { s0 = MFMA32(k0, qf[s], s0); s1 = MFMA32(k1, qf[s], s1); }
            }
            float mx = s0[0];
#pragma unroll
            for (int i = 1; i < 16; ++i) mx = fmaxf(mx, s0[i]);
#pragma unroll
            for (int i = 0; i < 16; ++i) mx = fmaxf(mx, s1[i]);
            mx = max32(mx);
            if (kt == 0 || __builtin_amdgcn_ballot_w64(mx > 8.f) != 0) {
                const float d = kt == 0 ? mx : fmaxf(mx, 0.f), alpha = kt == 0 ? 1.f : __builtin_amdgcn_exp2f(-d); mrun += d; lrun *= alpha;
#pragma unroll
                for (int i = 0; i < 16; ++i) { s0[i] -= d; s1[i] -= d; negm[i] -= d; o0[i] *= alpha; o1[i] *= alpha; }
            }
            float ls = 0.f;
#pragma unroll
            for (int i = 0; i < 16; ++i) { s0[i] = __builtin_amdgcn_exp2f(s0[i]); s1[i] = __builtin_amdgcn_exp2f(s1[i]); ls += s0[i] + s1[i]; }
            lrun += ls;
#pragma unroll
            for (int kb = 0; kb < 2; ++kb)
#pragma unroll
                for (int s = 0; s < 2; ++s) {
                    const bf16x8 pf = pack8(kb ? s1 : s0, s);
                    const int ko = (32 * kb + 16 * s + 8 * hh) * 2;
                    const bf16x8 va = *(const LAS bf16x8*)(Vb + r * MLA_VP + ko), vc = *(const LAS bf16x8*)(Vb + (32 + r) * MLA_VP + ko);
                    o0 = MFMA32(va, pf, o0);
                    o1 = MFMA32(vc, pf, o1);
                }
            __syncthreads();
        }
        const float inv = 1.f / sum32(lrun);
        bf16* op = O + (size_t)(q0 + r) * 1024 + 512 + h * 64 + 4 * hh;
#pragma unroll
        for (int g = 0; g < 4; ++g) {
            u32x2 w0, w1; w0.x = pk2(o0[4 * g] * inv, o0[4 * g + 1] * inv); w0.y = pk2(o0[4 * g + 2] * inv, o0[4 * g + 3] * inv);
            w1.x = pk2(o1[4 * g] * inv, o1[4 * g + 1] * inv); w1.y = pk2(o1[4 * g + 2] * inv, o1[4 * g + 3] * inv);
            *(u32x2*)(op + 8 * g) = w0; *(u32x2*)(op + 32 + 8 * g) = w1;
        }
    }
}

constexpr int NA_KP = 144, NA_VP = 144, NA_VOFF = 64 * NA_KP, NA_BUF = NA_VOFF + 64 * NA_VP, NA_BIAS = 2 * NA_BUF;
__device__ __forceinline__ void phase_na(const bf16* qk, const bf16* vt, const float* rpbl, bf16* O, LAS unsigned char* lds, int tid, int wave, int lane, int bid, int G) {
    LAS float* bias = (LAS float*)(lds + NA_BIAS);
    const int r32 = lane & 31, hh = lane >> 5;
    for (int ub = bid; ub < BATCH * 8 * 16; ub += G) {
        int bh = ub >> 4, rg = ub & 15;
        if (G == 256) { const int w = ub & 255, xcd = w & 7, slot = w >> 3; bh = (ub >> 8) * 16 + xcd * 2 + (slot >> 4); rg = slot & 15; }
        const int b = bh >> 3, h = bh & 7;
        for (int i = tid; i < 15 * 128; i += 512) { const int dcv = (i & 127) - 48; bias[i] = (dcv >= 0 && dcv <= 30) ? rpbl[h * 465 + (i >> 7) * 31 + dcv] * LOG2E : 0.f; }
        const int gr0 = rg * 4, gr = gr0 + (wave >> 1), half = wave & 1;
        const int rs = min(max(gr - 4, 0), 56);
        const int krlo = min(max(gr0 - 4, 0), 56), nrows = min(max(gr0 - 1, 0), 56) + 8 - krlo;
        const int c = half * 32 + r32, cs = min(max(c - 8, 0), 48);
        const size_t qtok = (size_t)b * SEQ + gr * 64 + c;
        bf16x8 qf[4];
#pragma unroll
        for (int s = 0; s < 4; ++s) qf[s] = *(const bf16x8*)(qk + qtok * 1024 + h * 64 + 16 * s + 8 * hh);
        f32x16 o0 = zero16(), o1 = zero16(); float mrun = -1e30f, lrun = 0.f;
        float mk[2][16];
#pragma unroll
        for (int t = 0; t < 2; ++t)
#pragma unroll
            for (int e = 0; e < 16; ++e) { const int kc = 32 * t + (e & 3) + 8 * (e >> 2) + 4 * hh; mk[t][e] = ((kc >= cs) && (kc < cs + 16)) ? 0.f : -INFINITY; }
        const int lanebase = 4 * hh - c + 15 + 48;
        const bf16* gK = qk + ((size_t)b * SEQ + krlo * 64 + (tid >> 3)) * 1024 + 512 + h * 64 + (tid & 7) * 8;  const int dK = (tid >> 3) * NA_KP + (tid & 7) * 16;
        const bf16* gV = vt + (size_t)(h * 64 + (tid >> 3)) * MTOK + (size_t)b * SEQ + krlo * 64 + (tid & 7) * 8; const int dV = NA_VOFF + (tid >> 3) * NA_VP + (16 * ((tid & 7) >> 1) + 4 * (tid & 1)) * 2;
        u32x4 rk = *(const u32x4*)gK, rv = *(const u32x4*)gV;
        *(LAS u32x4*)(lds + dK) = rk; *(LAS u32x2*)(lds + dV) = (u32x2){rv.x, rv.y}; *(LAS u32x2*)(lds + dV + 16) = (u32x2){rv.z, rv.w};
        __syncthreads();
        for (int j = 0; j < nrows; ++j) {
            const int kr = krlo + j, cur = j & 1; const bool more = j + 1 < nrows;
            LAS unsigned char* Kb = lds + cur * NA_BUF; LAS unsigned char* Vb = Kb + NA_VOFF;
            if (more) { rk = *(const u32x4*)(gK + (size_t)(j + 1) * 64 * 1024); rv = *(const u32x4*)(gV + (j + 1) * 64); }
            if (kr >= rs && kr < rs + 8) {
                const LAS float* brow = bias + (kr - gr + 7) * 128 + lanebase;
#pragma unroll
                for (int t = 0; t < 2; ++t) {
                    f32x16 sc = zero16();
#pragma unroll
                    for (int s = 0; s < 4; ++s) { const bf16x8 kf = *(const LAS bf16x8*)(Kb + (32 * t + r32) * NA_KP + (16 * s + 8 * hh) * 2); sc = MFMA32(kf, qf[s], sc); }
                    float mx = -INFINITY;
#pragma unroll
                    for (int e = 0; e < 16; ++e) { sc[e] = (sc[e] + brow[32 * t + (e & 3) + 8 * (e >> 2)]) + mk[t][e]; mx = fmaxf(mx, sc[e]); }
                    mx = max32(mx);
                    if (__builtin_amdgcn_ballot_w64(mx > mrun + 8.f) != 0) {
                        const float mnew = fmaxf(mrun, mx), alpha = __builtin_amdgcn_exp2f(mrun - mnew); mrun = mnew; lrun *= alpha;
#pragma unroll
                        for (int e = 0; e < 16; ++e) { o0[e] *= alpha; o1[e] *= alpha; }
                    }
                    float ls = 0.f;
#pragma unroll
                    for (int e = 0; e < 16; ++e) { sc[e] = __builtin_amdgcn_exp2f(sc[e] - mrun); ls += sc[e]; }
                    lrun += ls;
#pragma unroll
                    for (int s = 0; s < 2; ++s) {
                        const bf16x8 pf = pack8(sc, s);
                        const int ko = (32 * t + 16 * s + 8 * hh) * 2;
                        const bf16x8 va = *(const LAS bf16x8*)(Vb + r32 * NA_VP + ko), vc = *(const LAS bf16x8*)(Vb + (32 + r32) * NA_VP + ko);
                        o0 = MFMA32(va, pf, o0);
                        o1 = MFMA32(vc, pf, o1);
                    }
                }
            }
            if (more) { LAS unsigned char* nb = lds + (cur ^ 1) * NA_BUF;
                *(LAS u32x4*)(nb + dK) = rk; *(LAS u32x2*)(nb + dV) = (u32x2){rv.x, rv.y}; *(LAS u32x2*)(nb + dV + 16) = (u32x2){rv.z, rv.w}; }
            __syncthreads();
        }
        const float inv = 1.f / sum32(lrun);
        bf16* op = O + qtok * 1024 + h * 64 + 4 * hh;
#pragma unroll
        for (int g = 0; g < 4; ++g) {
            u32x2 w0, w1; w0.x = pk2(o0[4 * g] * inv, o0[4 * g + 1] * inv); w0.y = pk2(o0[4 * g + 2] * inv, o0[4 * g + 3] * inv);
            w1.x = pk2(o1[4 * g] * inv, o1[4 * g + 1] * inv); w1.y = pk2(o1[4 * g + 2] * inv, o1[4 * g + 3] * inv);
            *(u32x2*)(op + 8 * g) = w0; *(u32x2*)(op + 32 + 8 * g) = w1;
        }
    }
}

#define XB_TMO      128
#define XB_XCNT(j)  (256  + 64 * (j))
#define XB_XSUB(j)  (1280 + 64 * (j))
#define XB_XGEN(j)  (2304 + 64 * (j))
#define XB_TOP      3328
#define XB_TOPGEN   3392
#define XCD_BAR_WORDS 3456
#define XB_SPIN_CAP (1u << 18)

__device__ __forceinline__ unsigned xb_ld(unsigned* p)              { return __hip_atomic_load(p, __ATOMIC_RELAXED, __HIP_MEMORY_SCOPE_AGENT); }
__device__ __forceinline__ unsigned xb_add(unsigned* p, unsigned v) { return __hip_atomic_fetch_add(p, v, __ATOMIC_RELAXED, __HIP_MEMORY_SCOPE_AGENT); }
__device__ __forceinline__ unsigned xb_xcc_id() { return (unsigned)__builtin_amdgcn_s_getreg((3 << 11) | 20) & 0xFu; }
#define XB_SPIN(cond, bar) do { unsigned _sp = 0; while (cond) { __builtin_amdgcn_s_sleep(1); \
    if ((++_sp & 255u) == 0u) { if (xb_ld(&(bar)[XB_TMO])) break; if (_sp > XB_SPIN_CAP) { atomicAdd(&(bar)[XB_TMO], 1u); break; } } } } while (0)

struct XcdBarrier {
    unsigned* bar; unsigned x;
    volatile LAS unsigned* st;
};

__device__ __forceinline__ XcdBarrier xcd_barrier_post(unsigned* bar, volatile LAS unsigned* st, bool leader) {
    XcdBarrier b; b.bar = bar; b.x = xb_xcc_id(); b.st = st;
    if (leader) (void)xb_add(&bar[XB_XCNT(b.x)], 1u);
    return b;
}
__device__ __forceinline__ void xcd_barrier_complete(unsigned* bar, unsigned x, unsigned& nloc, unsigned& nx) {
    const unsigned G = gridDim.x * gridDim.y * gridDim.z;
    unsigned sum, cnt, mine, sp = 0u;
    for (;;) {
        sum = 0u; cnt = 0u; mine = 0u;
#pragma unroll
        for (unsigned j = 0; j < 16; ++j) { const unsigned c = xb_ld(&bar[XB_XCNT(j)]); sum += c; cnt += (c > 0u) ? 1u : 0u; mine = (j == x) ? c : mine; }
        if (sum == G) break;
        __builtin_amdgcn_s_sleep(1);
        if ((++sp & 255u) == 0u) { if (xb_ld(&bar[XB_TMO])) break; if (sp > XB_SPIN_CAP) { atomicAdd(&bar[XB_TMO], 1u); break; } }
    }
    nloc = mine > 0u ? mine : 1u; nx = cnt > 0u ? cnt : 1u;
}

__device__ __forceinline__ void xcd_barrier(const XcdBarrier& b, bool leader) {
    asm volatile("s_waitcnt vmcnt(0)" ::: "memory");
    __syncthreads();
    if (leader) {
        unsigned* bar = b.bar;
        __builtin_amdgcn_s_waitcnt(0);
        unsigned nloc = b.st[0], nx = b.st[1];
        if (nloc == 0u) { xcd_barrier_complete(bar, b.x, nloc, nx); b.st[0] = nloc; b.st[1] = nx; }
        const unsigned old = xb_add(&bar[XB_XSUB(b.x)], 1u);
        const unsigned gen = old / nloc;
        if (old + 1u == (gen + 1u) * nloc) {
            __builtin_amdgcn_fence(__ATOMIC_RELEASE, "agent");
            asm volatile("s_waitcnt vmcnt(0)" ::: "memory");
            const unsigned og = xb_add(&bar[XB_TOP], 1u);
            const unsigned tg = og / nx;
            if (og + 1u == (tg + 1u) * nx) xb_add(&bar[XB_TOPGEN], 1u);
            else XB_SPIN(xb_ld(&bar[XB_TOPGEN]) == tg, bar);
            __builtin_amdgcn_fence(__ATOMIC_ACQUIRE, "agent");
            xb_add(&bar[XB_XGEN(b.x)], 1u);
            asm volatile("s_waitcnt vmcnt(0)" ::: "memory");
        } else {
            XB_SPIN(xb_ld(&bar[XB_XGEN(b.x)]) == gen, bar);
            __builtin_amdgcn_fence(__ATOMIC_ACQUIRE, "agent");
            asm volatile("s_waitcnt vmcnt(0)" ::: "memory");
        }
    }
    __syncthreads();
}

constexpr int NSTEP_L = 14;
__global__ void __launch_bounds__(512, 2) mega(Args a) {
    extern __shared__ __attribute__((aligned(16))) unsigned char lds_raw[];
    LAS unsigned char* lds = (LAS unsigned char*)lds_raw;
    const int wave0 = __builtin_amdgcn_readfirstlane((int)threadIdx.x >> 6);
    const int ph_lo = a.ph_lo, ph_hi = a.ph_hi;
    { volatile LAS unsigned* bst0 = (volatile LAS unsigned*)(lds + 131072 + 512);
      if (threadIdx.x < 4) bst0[threadIdx.x] = 0u; }
    volatile LAS unsigned* bst = (volatile LAS unsigned*)(lds + 131072 + 512);
    __syncthreads();
    (void)xcd_barrier_post((unsigned*)as_global(a.ws + WS_CTL), bst, threadIdx.x == 0);
    for (int ph = ph_lo; ph < ph_hi; ++ph) {
        ArgsP ap = (ArgsP)__builtin_amdgcn_kernarg_segment_ptr(); asm volatile("" : "+s"(ap));
        float* const outp = as_global(ap->out);
        GAS unsigned char* wsg = (GAS unsigned char*)ap->ws; asm volatile("" : "+s"(wsg)); unsigned char* const ws = (unsigned char*)wsg;
        float* mod = (float*)(ws + WS_MOD);
        int bid = (int)blockIdx.x, G = (int)gridDim.x; asm volatile("" : "+s"(bid), "+s"(G));
#define TIDS() const int wave = wave0, lane = my_lane(), tid = wave * 64 + lane; \
        const int gw = bid * 8 + wave, NGW = G * 8; (void)gw; (void)NGW; (void)lane; (void)tid
        bool sync_after = true;
#ifdef DBG_STOP
        if (ph > DBG_STOP && ph < NPHASE - 1) continue;
#endif
        if (ph == 0) { if (PH_EN(10)) { TIDS(); phase_p0(ap, lds, tid, bid, G); __syncthreads(); phase_convert(ap, 0, lds, gw, NGW, wave, lane); } }
        else if (ph == NPHASE - 1) { if (PH_EN(11)) { TIDS(); phase_final_norm(outp, as_global((const float*)ap->in[19]), gw, NGW, lane, DBG_FINAL_SRC, as_global((const float*)ap->in[0])); } }
        else {
            const int l = (ph - 1) / NSTEP_L, st = (ph - 1) % NSTEP_L;
            const float* modl = mod + (size_t)l * 8 * 6144;
            const float* xin = (l == 0) ? as_global((const float*)ap->in[0]) : outp;
            sync_after = !(st == 1 || st == 3 || st == 4 || st == 5 || st == 8);
#ifdef PROBE_MASK
            for (int rep_ = 0; rep_ < (((PROBE_MASK >> st) & 1) ? 2 : 1); ++rep_)
#endif
            switch (st) {
            case 0: if (PH_EN(0)) {
                TIDS();
                if (l > 0) phase_convert(ap, l, lds, gw, NGW, wave, lane);
                __syncthreads();
                phase_sw(as_global((const float*)ap->in[6]) + (size_t)l * 1024 * 4000, as_global((const float*)ap->in[17]) + (size_t)l * 1024 * 4096, modl, (float*)(ws + WS_SWIN), (float*)(ws + WS_SWFF), lds, tid, bid, G);
                if (l == 0) phase_xg(xin, as_global((const float*)ap->in[5]), modl, 1024, (bf16*)(ws + WS_H), (float*)(ws + WS_RSTDA), gw, NGW, lane);
                else phase_rstd((const float*)(ws + WS_SSQX), (float*)(ws + WS_RSTDA), tid, bid, G);
            } break;
            case 1: if (PH_EN(1)) {
                EpiInProj E{ws, as_global((const float*)ap->in[7]) + l * 2048, 0.125f * LOG2E};
                run_gemm(lds, wave0, bid, G, (const bf16*)(ws + WS_H), (const bf16*)(ws + WS_WIN), MTOK, NIN, 1024, E);
            } break;
            case 2: if (PH_EN(2)) {
                EpiVtNa E2{ws};
                run_gemm(lds, wave0, bid, G, (const bf16*)(ws + WS_WVNA), (const bf16*)(ws + WS_H), 512, MTOK, 1024, E2);
            } break;
            case 3: if (PH_EN(3)) {
                TIDS();
                phase_na((const bf16*)(ws + WS_QKNA), (const bf16*)(ws + WS_VTNA), as_global((const float*)ap->in[8]) + (size_t)l * 8 * 465, (bf16*)(ws + WS_OCAT), lds, tid, wave, lane, bid, G);
#ifdef PROBE_NA2
                phase_na((const bf16*)(ws + WS_QKNA), (const bf16*)(ws + WS_VTNA), as_global((const float*)ap->in[8]) + (size_t)l * 8 * 465, (bf16*)(ws + WS_OCAT), lds, tid, wave, lane, bid, G);
#endif
            } break;
            case 4: if (PH_EN(4)) {
                EpiQup Eq{ws, 0.10206207261596577f * LOG2E};
                run_gemm(lds, wave0, bid, G, (const bf16*)(ws + WS_CQ), (const bf16*)(ws + WS_WUQ), MTOK, 768, 256, Eq);
            } break;
            case 5: if (PH_EN(5)) {
                EpiKup Ek{ws};
                run_gemm(lds, wave0, bid, G, (const bf16*)(ws + WS_CKV), (const bf16*)(ws + WS_WUK), MTOK, 512, 128, Ek);
            } break;
            case 6: if (PH_EN(6)) {
                EpiVtUp Ev{ws};
                run_gemm(lds, wave0, bid, G, (const bf16*)(ws + WS_WUV), (const bf16*)(ws + WS_CKV), 512, MTOK, 128, Ev);
            } break;
            case 7: if (PH_EN(7)) {
                TIDS();
                phase_mla((const bf16*)(ws + WS_QMLA), (const bf16*)(ws + WS_KNOPE), (const bf16*)(ws + WS_KRR), (const bf16*)(ws + WS_VTMLA), (bf16*)(ws + WS_OCAT), lds, tid, wave, lane, bid, G);
#ifdef PROBE_MLA2
                __syncthreads(); phase_mla((const bf16*)(ws + WS_QMLA), (const bf16*)(ws + WS_KNOPE), (const bf16*)(ws + WS_KRR), (const bf16*)(ws + WS_VTMLA), (bf16*)(ws + WS_OCAT), lds, tid, wave, lane, bid, G);
#endif
            } break;
            case 8: break;
            case 9: if (PH_EN(9)) {
                EpiBr E2{ws};
                run_gemm(lds, wave0, bid, G, (const bf16*)(ws + WS_OCAT), (const bf16*)(ws + WS_WBR), MTOK, 1024, 1024, E2);
            } break;
            case 10: if (PH_EN(12)) {
                EpiResid<4> E{xin, outp, modl + 2048, (bf16*)(ws + WS_HM), as_global((const float*)ap->in[16]) + l * DM, modl + 4096, (float*)(ws + WS_SSQX)};
                run_gemm(lds, wave0, bid, G, (const bf16*)(ws + WS_MERGED), (const bf16*)(ws + WS_WOUT), MTOK, 1024, 1024, E);
            } break;
            case 11: if (PH_EN(13)) {
                TIDS();
                phase_rstd((const float*)(ws + WS_SSQX), (float*)(ws + WS_RSTDM), tid, bid, G);
            } break;
            case 12: if (PH_EN(14)) {
                EpiFF1 E{ws};
                run_gemm(lds, wave0, bid, G, (const bf16*)(ws + WS_HM), (const bf16*)(ws + WS_WFF1), MTOK, DFF, 1024, E);
            } break;
            default: if (PH_EN(15)) {
                const bool nxt = l + 1 < DEPTH; const float* modn = modl + (size_t)8 * 6144;
                EpiResid<2> E{outp, outp, modl + 5120, nxt ? (bf16*)(ws + WS_H) : (bf16*)nullptr, as_global((const float*)ap->in[5]) + (l + 1) * DM, modn + 1024, (float*)(ws + WS_SSQX)};
                run_gemm(lds, wave0, bid, G, (const bf16*)(ws + WS_U), (const bf16*)(ws + WS_WFF2), MTOK, 1024, DFF, E);
            } break;
            }
        }
#ifdef DBG_STOP
        sync_after = true;
#endif
        if (sync_after && ph + 1 < ph_hi) { if (ph_hi > (1 << 20)) cg::this_grid().sync();
            { XcdBarrier xb; xb.bar = (unsigned*)(ws + WS_CTL); xb.x = xb_xcc_id(); xb.st = (volatile LAS unsigned*)(lds + 131072 + 512); xcd_barrier(xb, wave0 == 0 && my_lane() == 0); } }
    }
}

extern "C" void kernel_launch(void* const* d_in, const int* in_sizes, int n_in, void* d_out, int out_size, void* d_ws, size_t ws_size, hipStream_t stream) {
    static int grid = 0;
    if (grid == 0) {
        if (n_in != 20 || in_sizes[0] != MTOK * DM || out_size != MTOK * DM || ws_size < WS_NEED) {
            fprintf(stderr, "kernel_launch: unexpected shapes (n_in %d, in0 %d, out %d, ws %zu); nothing launched\n", n_in, n_in > 0 ? in_sizes[0] : -1, out_size, ws_size); grid = -1; return; }
        int dev = 0, cus = 0, per_cu = 0;
        hipGetDevice(&dev); hipDeviceGetAttribute(&cus, hipDeviceAttributeMultiprocessorCount, dev);
        hipFuncSetAttribute((const void*)mega, hipFuncAttributeMaxDynamicSharedMemorySize, LDS_BYTES);
        hipOccupancyMaxActiveBlocksPerMultiprocessor(&per_cu, (const void*)mega, 512, LDS_BYTES);
        if (per_cu < 1) per_cu = 1;
        grid = cus * per_cu;
        (void)hipGetLastError();
    }
    if (grid < 0) return;
    (void)hipMemsetAsync((char*)d_ws + WS_CTL, 0, 65536, stream);
    Args a{};
    for (int i = 0; i < 20; ++i) a.in[i] = d_in[i];
    a.out = (float*)d_out; a.ws = (unsigned char*)d_ws;
#if MK_MULTI
    for (int ph = 0; ph < NPHASE; ++ph) { a.ph_lo = ph; a.ph_hi = ph + 1; hipLaunchKernelGGL(mega, dim3(grid), dim3(512), LDS_BYTES, stream, a); }
#else
    a.ph_lo = 0; a.ph_hi = NPHASE;
    void* args[] = {&a};
    hipError_t e = hipLaunchCooperativeKernel((const void*)mega, dim3(grid), dim3(512), args, LDS_BYTES, stream);
    if (e != hipSuccess) fprintf(stderr, "cooperative launch failed: %s (grid %d)\n", hipGetErrorString(e), grid);
#endif
}
```
